# Optimizing an MI355X kernel written in HIP

```python
import math
import jax
import jax.numpy as jnp
from jax import lax
import numpy as np

D_MODEL = 2048
BATCH = 16
SEQ = 2048
DEPTH = 4

GRID_W = 64
CTX_LEN = 256
N_BRANCH = 4
BRANCH_W = D_MODEL // N_BRANCH
MIX_W = N_BRANCH * BRANCH_W
NORM_EPS = 1e-6
F32 = jnp.float32
S5_H = 16
S5_G = BRANCH_W // S5_H
S5_P = 64
HEAD_DIM = 64
ATT_HEADS = BRANCH_W // HEAD_DIM
ATT_KV_HEADS = 2
ATT_REP = ATT_HEADS // ATT_KV_HEADS
WINDOW = 128
BLOCK = 128
ROPE_BASE = 10000.0
NEG_INF = -1e30
RW_N = 64
RW_HEADS = BRANCH_W // RW_N
RW_LORA = 32
RW_SHIFT_W = 3 * BRANCH_W + 4 * RW_LORA
RW_LN_EPS = 64e-5
HY_ORDER = 2
HY_EMB = 33
HY_BANDS = (HY_EMB - 1) // 2
HY_FFN = 64
HY_N_FILT = 2 * HY_ORDER
HY_TARGET = 1e-2
HY_FAST_PCT = 0.3
HY_SLOW_PCT = 1.5
P_S5 = BRANCH_W
P_Q = ATT_HEADS * HEAD_DIM
P_KV = ATT_KV_HEADS * HEAD_DIM
P_RKV = 3 * BRANCH_W
P_LORA = 4 * RW_LORA
P_HY = (HY_ORDER + 1) * BRANCH_W
P_GATE = MIX_W
D_IN = P_S5 + P_Q + 2 * P_KV + P_RKV + P_LORA + P_HY + P_GATE

kernel_name = 'hybrid_parallel_heads_dit_block'


def rms_norm(x, g, eps=NORM_EPS):
    xf = x.astype(F32)
    y = xf * lax.rsqrt(jnp.mean(xf * xf, axis=-1, keepdims=True) + eps)
    return (y * g.astype(F32)).astype(x.dtype)


def centred_shift(z):
    prev = jnp.pad(z[:, :-1], ((0, 0), (1, 0), (0, 0)))
    nxt = jnp.pad(z[:, 1:], ((0, 0), (0, 1), (0, 0)))
    return prev, nxt


def centred_conv3(z, w, b):
    prev, nxt = centred_shift(z)
    return prev * w[0] + z * w[1] + nxt * w[2] + b


def split_proj(p):
    sizes = (P_S5, P_Q, P_KV, P_KV, P_RKV, P_LORA, P_HY, P_GATE)
    parts, start = [], 0
    for s in sizes:
        parts.append(p[..., start:start + s])
        start += s
    return parts


def s5_discretise(lam_re, lam_im, log_step, b_re, b_im):
    lam_re, lam_im = lam_re.astype(F32), lam_im.astype(F32)
    step = jnp.exp(log_step.astype(F32))[:, None]
    mag = jnp.exp(lam_re * step)
    lb_re, lb_im = mag * jnp.cos(lam_im * step), mag * jnp.sin(lam_im * step)
    den = lam_re * lam_re + lam_im * lam_im
    nr = lb_re - 1.0
    co_re = (nr * lam_re + lb_im * lam_im) / den
    co_im = (lb_im * lam_re - nr * lam_im) / den
    b_re, b_im = b_re.astype(F32), b_im.astype(F32)
    bb_re = co_re[..., None] * b_re - co_im[..., None] * b_im
    bb_im = co_re[..., None] * b_im + co_im[..., None] * b_re
    return lb_re, lb_im, bb_re, bb_im


def _ssm_combine(e1, e2):
    a1r, a1i, b1r, b1i = e1
    a2r, a2i, b2r, b2i = e2
    return (a2r * a1r - a2i * a1i, a2r * a1i + a2i * a1r,
            a2r * b1r - a2i * b1i + b2r, a2r * b1i + a2i * b1r + b2i)


def s5_states(lb_re, lb_im, bb_re, bb_im, u_tm, reverse, h0):
    if reverse:
        u_tm = u_tm[::-1]
    bu_re = jnp.einsum('lbgh,gph->lbgp', u_tm, bb_re)
    bu_im = jnp.einsum('lbgh,gph->lbgp', u_tm, bb_im)
    shape = (u_tm.shape[0], 1) + lb_re.shape
    a_re, a_im, h_re, h_im = lax.associative_scan(
        _ssm_combine,
        (jnp.broadcast_to(lb_re, shape), jnp.broadcast_to(lb_im, shape), bu_re, bu_im), axis=0)
    if h0 is not None:
        h_re, h_im = (h_re + a_re * h0[0] - a_im * h0[1],
                      h_im + a_re * h0[1] + a_im * h0[0])
    return h_re, h_im


def s5_readout(h, c_re, c_im, reverse):
    y = jnp.einsum('lbgp,ghp->lbgh', h[0], c_re) - jnp.einsum('lbgp,ghp->lbgh', h[1], c_im)
    return y[::-1] if reverse else y


def s5_mixer(u_lat, u_ctx, lam_re, lam_im, log_step, b_re, b_im, c_re, c_im, d_skip,
             glu_w, glu_b, ctx_out):
    dtype = u_lat.dtype

    def to_tm(u):
        return jnp.swapaxes(u.astype(F32).reshape(u.shape[0], u.shape[1], S5_G, S5_H), 0, 1)

    ul, uc = to_tm(u_lat), to_tm(u_ctx)
    d = d_skip.astype(F32)
    y_lat = d * ul
    y_ctx = d * uc if ctx_out else None
    for di, rev in enumerate((False, True)):
        lb_re, lb_im, bb_re, bb_im = s5_discretise(lam_re[di], lam_im[di], log_step[di],
                                                   b_re[di], b_im[di])
        cr, ci = c_re[di].astype(F32), c_im[di].astype(F32)
        hc = s5_states(lb_re, lb_im, bb_re, bb_im, uc, rev, None)
        hl = s5_states(lb_re, lb_im, bb_re, bb_im, ul, rev, (hc[0][-1], hc[1][-1]))
        y_lat = y_lat + s5_readout(hl, cr, ci, rev)
        if ctx_out:
            y_ctx = y_ctx + s5_readout(hc, cr, ci, rev)

    def glu(y_tm):
        y = jnp.swapaxes(y_tm, 0, 1)
        y = jax.nn.gelu(y.reshape(y.shape[0], y.shape[1], BRANCH_W), approximate=False)
        y = y * jax.nn.sigmoid(y @ glu_w.astype(F32) + glu_b.astype(F32))
        return y.astype(dtype)

    return glu(y_lat), (glu(y_ctx) if ctx_out else None)


def axial_rope(t, row, col):
    half = HEAD_DIM // 2
    quarter = half // 2
    inv = 1.0 / (ROPE_BASE ** (jnp.arange(quarter, dtype=F32) / quarter))

    def rot(u, pos):
        ang = pos.astype(F32)[:, None] * inv[None, :]
        cos, sin = jnp.cos(ang)[None, :, None, :], jnp.sin(ang)[None, :, None, :]
        u = u.astype(F32)
        u1, u2 = u[..., :quarter], u[..., quarter:]
        return jnp.concatenate([u1 * cos - u2 * sin, u2 * cos + u1 * sin], axis=-1)

    return jnp.concatenate([rot(t[..., :half], row), rot(t[..., half:], col)], axis=-1).astype(t.dtype)


def attn_mixer(q_l, k_l, v_l, q_c, k_c, v_c, q_g, k_g, sink, row, col, ctx_out):
    b_, n_, _ = q_l.shape
    n_ctx = k_c.shape[1]

    def heads(t, h):
        return t.reshape(t.shape[0], t.shape[1], h, HEAD_DIM)

    q = axial_rope(rms_norm(heads(q_l, ATT_HEADS), q_g), row, col)
    k = axial_rope(rms_norm(heads(k_l, ATT_KV_HEADS), k_g), row, col)
    v = heads(v_l, ATT_KV_HEADS)
    kc = rms_norm(heads(k_c, ATT_KV_HEADS), k_g)
    vc = heads(v_c, ATT_KV_HEADS)
    scale = HEAD_DIM ** -0.5
    sink_f = sink.astype(F32).reshape(ATT_KV_HEADS, ATT_REP)

    nb = n_ // BLOCK
    qb = q.reshape(b_, nb, BLOCK, ATT_KV_HEADS, ATT_REP, HEAD_DIM)

    def band(t):
        tp = jnp.pad(t, ((0, 0), (BLOCK, BLOCK), (0, 0), (0, 0)))
        tp = tp.reshape(b_, nb + 2, BLOCK, ATT_KV_HEADS, HEAD_DIM)
        return jnp.concatenate([tp[:, :-2], tp[:, 1:-1], tp[:, 2:]], axis=2)

    kw, vw = band(k), band(v)
    qpos = jnp.arange(nb)[:, None] * BLOCK + jnp.arange(BLOCK)[None, :]
    kpos = jnp.arange(nb)[:, None] * BLOCK - BLOCK + jnp.arange(3 * BLOCK)[None, :]
    valid = ((jnp.abs(qpos[:, :, None] - kpos[:, None, :]) <= WINDOW)
             & ((kpos >= 0) & (kpos < n_))[:, None, :])
    s_loc = jnp.einsum('bnqhrd,bnkhd->bnhrqk', qb, kw).astype(F32) * scale
    s_loc = jnp.where(valid[None, :, None, None], s_loc, NEG_INF)
    s_ctx = jnp.einsum('bnqhrd,bchd->bnhrqc', qb, kc).astype(F32) * scale
    s_sink = jnp.broadcast_to(sink_f[None, None, :, :, None, None], s_loc.shape[:-1] + (1,))
    p = jax.nn.softmax(jnp.concatenate([s_loc, s_ctx, s_sink], axis=-1), axis=-1).astype(v.dtype)
    o = (jnp.einsum('bnhrqk,bnkhd->bnqhrd', p[..., :3 * BLOCK], vw)
         + jnp.einsum('bnhrqc,bchd->bnqhrd', p[..., 3 * BLOCK:3 * BLOCK + n_ctx], vc))
    o_lat = o.reshape(b_, n_, ATT_HEADS * HEAD_DIM)

    o_ctx = None
    if ctx_out:
        qc = rms_norm(heads(q_c, ATT_HEADS), q_g).reshape(b_, n_ctx, ATT_KV_HEADS, ATT_REP, HEAD_DIM)
        s = jnp.einsum('bqhrd,bchd->bhrqc', qc, kc).astype(F32) * scale
        s_sink_c = jnp.broadcast_to(sink_f[None, :, :, None, None], s.shape[:-1] + (1,))
        pc = jax.nn.softmax(jnp.concatenate([s, s_sink_c], axis=-1), axis=-1).astype(vc.dtype)
        o_ctx = jnp.einsum('bhrqc,bchd->bqhrd', pc[..., :n_ctx], vc).reshape(b_, n_ctx, ATT_HEADS * HEAD_DIM)
    return o_lat, o_ctx


def rwkv_features(rkv, lora, mu_prev, mu_next):
    z = jnp.concatenate([rkv, lora], axis=-1).astype(F32)
    prev, nxt = centred_shift(z)
    z = z + mu_prev * (prev - z) + mu_next * (nxt - z)
    b_, l_, _ = z.shape

    def heads(t):
        return t.reshape(b_, l_, RW_HEADS, RW_N)

    r = heads(z[..., :BRANCH_W])
    k = heads(z[..., BRANCH_W:2 * BRANCH_W])
    v = heads(z[..., 2 * BRANCH_W:3 * BRANCH_W])
    return r, k, v, z[..., 3 * BRANCH_W:]


def rwkv_kk(k, k_k):
    kk = k * k_k
    return kk * lax.rsqrt(jnp.sum(kk * kk, axis=-1, keepdims=True) + 1e-12)


def rwkv_direction(k, kk, lora, di, w0, w2, a0, a2, k_a):
    b_, l_ = k.shape[:2]
    wl = lora[..., di * RW_LORA:(di + 1) * RW_LORA]
    al = lora[..., (2 + di) * RW_LORA:(3 + di) * RW_LORA]
    w_log = -jax.nn.softplus(-(w0[di].astype(F32) + jnp.tanh(wl) @ w2[di].astype(F32))) - 0.5
    decay = jnp.exp(-jnp.exp(w_log)).reshape(b_, l_, RW_HEADS, RW_N)
    a = jax.nn.sigmoid(a0[di].astype(F32) + al @ a2[di].astype(F32)).reshape(b_, l_, RW_HEADS, RW_N)
    return decay, k * (1.0 + (a - 1.0) * k_a), kk * a


def _rwkv_step(state, inp):
    r_t, w_t, k_t, v_t, kk_t, b_t = inp
    sa = jnp.einsum('bhij,bhj->bhi', state, -kk_t)
    state = (state * w_t[:, :, None, :] + sa[..., None] * b_t[:, :, None, :]
             + v_t[..., None] * k_t[:, :, None, :])
    return state, jnp.einsum('bhij,bhj->bhi', state, r_t)


def rwkv_run(r, decay, k, v, kk, b, s0, reverse):
    def tm(t):
        t = jnp.swapaxes(t, 0, 1)
        return t[::-1] if reverse else t

    s_fin, y = lax.scan(_rwkv_step, s0, (tm(r), tm(decay), tm(k), tm(v), tm(kk), tm(b)))
    y = y[::-1] if reverse else y
    return s_fin, jnp.swapaxes(y, 0, 1)


def rwkv_mixer(rkv_l, lora_l, rkv_c, lora_c, mu_prev, mu_next, w0, w2, a0, a2,
               k_k, k_a, r_k, ln_g, ln_b, ctx_out):
    dtype = rkv_l.dtype
    mu_prev, mu_next = mu_prev.astype(F32), mu_next.astype(F32)
    k_k = k_k.astype(F32).reshape(RW_HEADS, RW_N)
    k_a = k_a.astype(F32).reshape(RW_HEADS, RW_N)
    r_k = r_k.astype(F32)
    lat = rwkv_features(rkv_l, lora_l, mu_prev, mu_next)
    ctx = rwkv_features(rkv_c, lora_c, mu_prev, mu_next)
    kk_l, kk_c = rwkv_kk(lat[1], k_k), rwkv_kk(ctx[1], k_k)
    b_ = rkv_l.shape[0]
    y_l, bonus_l = jnp.zeros_like(lat[0]), jnp.zeros_like(lat[0][..., :1])
    y_c, bonus_c = jnp.zeros_like(ctx[0]), jnp.zeros_like(ctx[0][..., :1])
    for di, rev in enumerate((False, True)):
        dec_c, kd_c, b_c = rwkv_direction(ctx[1], kk_c, ctx[3], di, w0, w2, a0, a2, k_a)
        dec_l, kd_l, b_l = rwkv_direction(lat[1], kk_l, lat[3], di, w0, w2, a0, a2, k_a)
        s0 = jnp.zeros((b_, RW_HEADS, RW_N, RW_N), F32)
        s_c, yc = rwkv_run(ctx[0], dec_c, kd_c, ctx[2], kk_c, b_c, s0, rev)
        _, yl = rwkv_run(lat[0], dec_l, kd_l, lat[2], kk_l, b_l, s_c, rev)
        y_l = y_l + yl
        bonus_l = bonus_l + jnp.sum(lat[0] * kd_l * r_k, axis=-1, keepdims=True)
        if ctx_out:
            y_c = y_c + yc
            bonus_c = bonus_c + jnp.sum(ctx[0] * kd_c * r_k, axis=-1, keepdims=True)

    def finish(y, bonus, v):
        mu = jnp.mean(y, axis=-1, keepdims=True)
        var = jnp.mean(jnp.square(y - mu), axis=-1, keepdims=True)
        y = (y - mu) * lax.rsqrt(var + RW_LN_EPS)
        bb, ll = y.shape[:2]
        y = y.reshape(bb, ll, BRANCH_W) * ln_g.astype(F32) + ln_b.astype(F32)
        return (y + (bonus * v).reshape(bb, ll, BRANCH_W)).astype(dtype)

    return finish(y_l, bonus_l, lat[2]), (finish(y_c, bonus_c, ctx[2]) if ctx_out else None)


def hyena_filters(n, w1, b1, f1, w2, b2, f2, w3):
    t = jnp.linspace(0.0, 1.0, n, dtype=F32)[:, None]
    ang = 2.0 * math.pi * jnp.arange(n, dtype=F32)[:, None] / n
    bands = jnp.linspace(1e-4, HY_BANDS - 1, HY_BANDS, dtype=F32)[None, :]
    z = jnp.concatenate([t, jnp.cos(bands * ang), -jnp.sin(bands * ang)], axis=-1)
    h = jnp.sin(f1.astype(F32) * (z @ w1.astype(F32) + b1.astype(F32)))
    h = jnp.sin(f2.astype(F32) * (h @ w2.astype(F32) + b2.astype(F32)))
    h = (h @ w3.astype(F32)).reshape(n, HY_N_FILT, BRANCH_W)
    deltas = jnp.abs(jnp.linspace(math.log(HY_TARGET) / HY_SLOW_PCT, math.log(HY_TARGET) / HY_FAST_PCT,
                                  BRANCH_W, dtype=F32))
    return h * jnp.exp(-t[:, :, None] * deltas)


def bidir_fftconv(u, h_f, h_b, skip):
    n = u.shape[1]
    g = jnp.concatenate([h_f, jnp.zeros_like(h_f[:1]), h_b[1:][::-1]], axis=0)
    gf = jnp.fft.rfft(g, axis=0)
    uf = jnp.fft.rfft(u, n=2 * n, axis=1)
    y = jnp.fft.irfft(uf * gf[None], n=2 * n, axis=1)[:, :n]
    return y + skip * u


def hyena_seq(z, conv_w, conv_b, w1, b1, f1, w2, b2, f2, w3, skip):
    dtype = z.dtype
    z = centred_conv3(z.astype(F32), conv_w.astype(F32), conv_b.astype(F32))
    v, x1, x2 = z[..., :BRANCH_W], z[..., BRANCH_W:2 * BRANCH_W], z[..., 2 * BRANCH_W:]
    h = hyena_filters(z.shape[1], w1, b1, f1, w2, b2, f2, w3)
    skip = skip.astype(F32)
    y = x1 * bidir_fftconv(v, h[:, 0], h[:, 1], skip[0])
    y = x2 * bidir_fftconv(y, h[:, 2], h[:, 3], skip[1])
    return y.astype(dtype)


def merge_heads(y_s5, y_att, y_rw, y_hy, gate_pre, branch_g, w_out):
    y = jnp.concatenate([rms_norm(y_s5, branch_g[0]), rms_norm(y_att, branch_g[1]), y_rw,
                         rms_norm(y_hy, branch_g[2])], axis=-1)
    return (y * jax.nn.silu(gate_pre)) @ w_out


def setup_inputs(seed: int = 0) -> dict:
    key = jax.random.key(seed)
    keys = iter(jax.random.split(key, 64))
    W = BRANCH_W

    def nrm(shape, std):
        return std * jax.random.normal(next(keys), shape, F32)

    def uni(shape, lo, hi):
        return jax.random.uniform(next(keys), shape, F32, lo, hi)

    s5_n = jnp.arange(S5_P, dtype=F32)
    return {
        'x': nrm((BATCH, SEQ, D_MODEL), 1.0),
        'c': nrm((BATCH, D_MODEL), 1.0),
        'ctx': nrm((BATCH, CTX_LEN, D_MODEL), 1.0),
        'c_ctx': nrm((D_MODEL,), 1.0),
        'norm_g': 1.0 + nrm((DEPTH, D_MODEL), 0.02),
        'w_ada': nrm((DEPTH, D_MODEL, 3 * D_MODEL), 0.5 * D_MODEL ** -0.5),
        'b_ada': nrm((DEPTH, 3 * D_MODEL), 0.02),
        'w_in': nrm((DEPTH, D_MODEL, D_IN), D_MODEL ** -0.5),
        'w_out': nrm((DEPTH, MIX_W, D_MODEL), MIX_W ** -0.5),
        'branch_g': 1.0 + nrm((DEPTH, 3, W), 0.02),
        's5_lam_re': -0.5 + nrm((DEPTH, 2, S5_G, S5_P), 0.01),
        's5_lam_im': math.pi * s5_n + nrm((DEPTH, 2, S5_G, S5_P), 0.01),
        's5_log_step': uni((DEPTH, 2, S5_G), math.log(1e-3), math.log(1e-1)),
        's5_b_re': nrm((DEPTH, 2, S5_G, S5_P, S5_H), (2 * S5_H) ** -0.5),
        's5_b_im': nrm((DEPTH, 2, S5_G, S5_P, S5_H), (2 * S5_H) ** -0.5),
        's5_c_re': nrm((DEPTH, 2, S5_G, S5_H, S5_P), (2 * S5_P) ** -0.5),
        's5_c_im': nrm((DEPTH, 2, S5_G, S5_H, S5_P), (2 * S5_P) ** -0.5),
        's5_d': nrm((DEPTH, S5_G, S5_H), 1.0),
        's5_glu_w': nrm((DEPTH, W, W), W ** -0.5),
        's5_glu_b': nrm((DEPTH, W), 0.02),
        'att_q_g': 1.0 + nrm((DEPTH, HEAD_DIM), 0.02),
        'att_k_g': 1.0 + nrm((DEPTH, HEAD_DIM), 0.02),
        'att_sink': nrm((DEPTH, ATT_HEADS), 0.5),
        'rw_mu_prev': uni((DEPTH, RW_SHIFT_W), 0.0, 0.5),
        'rw_mu_next': uni((DEPTH, RW_SHIFT_W), 0.0, 0.5),
        'rw_w0': jnp.linspace(-6.0, -1.0, W, dtype=F32) + nrm((DEPTH, 2, W), 0.1),
        'rw_w2': nrm((DEPTH, 2, RW_LORA, W), 0.1),
        'rw_a0': nrm((DEPTH, 2, W), 0.1),
        'rw_a2': nrm((DEPTH, 2, RW_LORA, W), 0.1),
        'rw_k_k': 0.85 + nrm((DEPTH, W), 0.02),
        'rw_k_a': 1.0 + nrm((DEPTH, W), 0.02),
        'rw_r_k': nrm((DEPTH, RW_HEADS, RW_N), 0.1),
        'rw_ln_g': 1.0 + nrm((DEPTH, W), 0.02),
        'rw_ln_b': nrm((DEPTH, W), 0.02),
        'hy_conv_w': nrm((DEPTH, 3, 3 * W), 3 ** -0.5),
        'hy_conv_b': nrm((DEPTH, 3 * W), 0.02),
        'hy_w1': nrm((DEPTH, HY_EMB, HY_FFN), HY_EMB ** -0.5),
        'hy_b1': nrm((DEPTH, HY_FFN), 0.1),
        'hy_f1': 1.0 + nrm((DEPTH, HY_FFN), 0.05),
        'hy_w2': nrm((DEPTH, HY_FFN, HY_FFN), HY_FFN ** -0.5),
        'hy_b2': nrm((DEPTH, HY_FFN), 0.1),
        'hy_f2': 1.0 + nrm((DEPTH, HY_FFN), 0.05),
        'hy_w3': nrm((DEPTH, HY_FFN, HY_N_FILT * W), HY_FFN ** -0.5),
        'hy_skip': nrm((DEPTH, 2, W), 0.5),
    }


def reference(x, c, ctx, c_ctx, norm_g, w_ada, b_ada, w_in, w_out, branch_g,
              s5_lam_re, s5_lam_im, s5_log_step, s5_b_re, s5_b_im, s5_c_re, s5_c_im, s5_d,
              s5_glu_w, s5_glu_b, att_q_g, att_k_g, att_sink,
              rw_mu_prev, rw_mu_next, rw_w0, rw_w2, rw_a0, rw_a2, rw_k_k, rw_k_a, rw_r_k,
              rw_ln_g, rw_ln_b, hy_conv_w, hy_conv_b, hy_w1, hy_b1, hy_f1, hy_w2, hy_b2, hy_f2,
              hy_w3, hy_skip):
    n_tok = x.shape[1]
    rows = n_tok // GRID_W
    row = jnp.repeat(jnp.arange(rows, dtype=jnp.int32), GRID_W)
    col = jnp.tile(jnp.arange(GRID_W, dtype=jnp.int32), rows)
    xc = ctx
    silu_c, silu_cc = jax.nn.silu(c), jax.nn.silu(c_ctx)
    for l in range(DEPTH):
        ctx_out = l < DEPTH - 1
        mod_x = silu_c @ w_ada[l] + b_ada[l]
        shift_x, scale_x, gate_x = jnp.split(mod_x[:, None, :], 3, axis=-1)
        mod_c = silu_cc @ w_ada[l] + b_ada[l]
        shift_c, scale_c, gate_c = jnp.split(mod_c, 3)
        hx = rms_norm(x, norm_g[l]) * (1.0 + scale_x) + shift_x
        hc = rms_norm(xc, norm_g[l]) * (1.0 + scale_c) + shift_c
        s5u_l, q_l, k_l, v_l, rkv_l, lora_l, hy_l, g_l = split_proj(hx @ w_in[l])
        s5u_c, q_c, k_c, v_c, rkv_c, lora_c, hy_c, g_c = split_proj(hc @ w_in[l])

        y_s5_l, y_s5_c = s5_mixer(s5u_l, s5u_c, s5_lam_re[l], s5_lam_im[l], s5_log_step[l],
                                  s5_b_re[l], s5_b_im[l], s5_c_re[l], s5_c_im[l], s5_d[l],
                                  s5_glu_w[l], s5_glu_b[l], ctx_out)
        y_att_l, y_att_c = attn_mixer(q_l, k_l, v_l, q_c, k_c, v_c, att_q_g[l], att_k_g[l],
                                      att_sink[l], row, col, ctx_out)
        y_rw_l, y_rw_c = rwkv_mixer(rkv_l, lora_l, rkv_c, lora_c, rw_mu_prev[l], rw_mu_next[l],
                                    rw_w0[l], rw_w2[l], rw_a0[l], rw_a2[l], rw_k_k[l], rw_k_a[l],
                                    rw_r_k[l], rw_ln_g[l], rw_ln_b[l], ctx_out)
        y_hy_l = hyena_seq(hy_l, hy_conv_w[l], hy_conv_b[l], hy_w1[l], hy_b1[l], hy_f1[l],
                           hy_w2[l], hy_b2[l], hy_f2[l], hy_w3[l], hy_skip[l])
        x = x + gate_x * merge_heads(y_s5_l, y_att_l, y_rw_l, y_hy_l, g_l, branch_g[l], w_out[l])
        if ctx_out:
            y_hy_c = hyena_seq(hy_c, hy_conv_w[l], hy_conv_b[l], hy_w1[l], hy_b1[l], hy_f1[l],
                               hy_w2[l], hy_b2[l], hy_f2[l], hy_w3[l], hy_skip[l])
            xc = xc + gate_c * merge_heads(y_s5_c, y_att_c, y_rw_c, y_hy_c, g_c, branch_g[l], w_out[l])
    return x
```

```cpp
#include <hip/hip_runtime.h>
#include <hip/hip_cooperative_groups.h>
#include <cstdio>
#include <cstdint>
namespace cg = cooperative_groups;
namespace pg8 {
#define PG8_LAS __attribute__((address_space(3)))
typedef unsigned short bf16_t;
typedef short bf16x8 __attribute__((ext_vector_type(8)));
typedef float f32x4 __attribute__((ext_vector_type(4)));
typedef unsigned u32x4 __attribute__((ext_vector_type(4)));
constexpr int BM = 256, BK = 64, HALF = 128, HTB = HALF * BK * 2  , STAGE_BYTES = 8 * HTB, NXCD = 8, WGM = 8;

__host__ __device__ __forceinline__ int lds_byte(int r, int c) { const int st = (r >> 4) * 2 + (c >> 5), rr = r & 15, cc = c & 31, ob = rr * 64 + cc * 2; return st * 1024 + (ob ^ (((ob >> 9) & 1) << 5)); }
__host__ __device__ __forceinline__ void stage_rc(int b, int& R, int& C) { const int st = b / 1024, sb = b % 1024, swz = sb ^ (((sb >> 9) & 1) << 5); R = (st >> 1) * 16 + swz / 64; C = (st & 1) * 32 + (swz % 64) / 2; }
__host__ __device__ __forceinline__ int perm32(int rho) { const int n = rho >> 4, i = rho & 15; return 8 * (i >> 2) + 4 * n + (i & 3); }

struct Unit { int pm, pn, w; };
struct Gemm { const bf16_t* A; const bf16_t* Bt; int M, N, K; const bf16_t* A2; const bf16_t* Bt2; };

struct StaticOrder {
    int nM, nN, nwg, G, c;
    __host__ __device__ void init(int M, int N, int G_, int c_) { nM = M / BM; nN = N / BM; nwg = nM * nN; G = G_; c = c_; }
    __host__ __device__ bool next(int i, Unit& u) const {
        const long L = (long)i * G + c; if (L >= nwg) return false;
        int wgid = (int)L; { const int q = nwg / NXCD, r = nwg % NXCD, xcd = wgid % NXCD, off = wgid / NXCD; wgid = (xcd < r ? xcd * (q + 1) : r * (q + 1) + (xcd - r) * q) + off; }
        const int nig = WGM * nN, gid = wgid / nig, fm = gid * WGM, gsz = (nM - fm) < WGM ? (nM - fm) : WGM;
        u.pm = fm + ((wgid % nig) % gsz); u.pn = (wgid % nig) / gsz; u.w = 0; return true;
    }
    __device__ __forceinline__ void a_ready(const Unit&) const {}
    __device__ __forceinline__ void done(const Unit&) const {}
};

struct DualOrder {
    int nM0, nN0, nwg0, nM1, nN1, nwg1, G, c;
    __host__ __device__ void init(int M0, int N0, int M1, int N1, int G_, int c_) { nM0 = M0 / BM; nN0 = N0 / BM; nwg0 = nM0 * nN0; nM1 = M1 / BM; nN1 = N1 / BM; nwg1 = nM1 * nN1; G = G_; c = c_; }
    __host__ __device__ bool next(int i, Unit& u) const {
        long L = (long)i * G + c; if (L >= nwg0 + nwg1) return false;
        const int w = L >= nwg0; if (w) L -= nwg0;
        const int nM = w ? nM1 : nM0, nN = w ? nN1 : nN0, nwg = w ? nwg1 : nwg0;
        int wgid = (int)L; { const int q = nwg / NXCD, r = nwg % NXCD, xcd = wgid % NXCD, off = wgid / NXCD; wgid = (xcd < r ? xcd * (q + 1) : r * (q + 1) + (xcd - r) * q) + off; }
        const int nig = WGM * nN, gid = wgid / nig, fm = gid * WGM, gsz = (nM - fm) < WGM ? (nM - fm) : WGM;
        u.pm = fm + ((wgid % nig) % gsz); u.pn = (wgid % nig) / gsz; u.w = w; return true;
    }
    __device__ __forceinline__ void a_ready(const Unit&) const {}
    __device__ __forceinline__ void done(const Unit&) const {}
};

__device__ __forceinline__ unsigned cvt_pk_bf16(float lo, float hi) { unsigned r; asm volatile("v_cvt_pk_bf16_f32 %0, %1, %2" : "=v"(r) : "v"(lo), "v"(hi)); return r; }
typedef float f32x2 __attribute__((ext_vector_type(2)));
__device__ __forceinline__ f32x2 gelu_pk(f32x2 v) {
    const f32x2 av = __builtin_elementwise_abs(v), d = av * 0.2316418882f + 1.0f;
    f32x2 t; t.x = __builtin_amdgcn_rcpf(d.x); t.y = __builtin_amdgcn_rcpf(d.y);
    f32x2 q = t * 0.5307027145f + (-0.7265760135f); q = q * t + 0.7107068705f; q = q * t + (-0.142248368f); q = q * t + 0.127414796f; q = q * t;
    const f32x2 s = (v * v) * (-0.72134752044f);
    f32x2 e; e.x = __builtin_amdgcn_exp2f(s.x); e.y = __builtin_amdgcn_exp2f(s.y);
    const f32x2 m = v * (q * e), r = v - m;
    f32x2 o; o.x = v.x < 0.f ? m.x : r.x; o.y = v.y < 0.f ? m.y : r.y; return o;
}

template <int ACT  > struct EpiBf16 {
    static constexpr bool PERM = true, AFTER_DRAIN = false; static_assert(ACT == 0 || ACT == 1, "EpiBf16: ACT is 0 (none) or 1 (gelu_pk)");
    bf16_t* O; int ldc; const float* bias; int split_cols; size_t split_stride; float scale0; bf16_t* O2; int ldc2;
    __device__ __forceinline__ void operator()(const f32x4 (&acc)[2][2][4][2], const Unit& u, int wr, int wc, int fr, int fq) const {
        const int row0 = u.pm * BM + wr * 64 + fr; int colt = u.pn * BM; bf16_t* base = u.w ? O2 : O; const int ldc = u.w ? ldc2 : this->ldc;
        float sc = 1.f; if (split_cols) { const int t = colt / split_cols; base += (size_t)t * split_stride; colt -= t * split_cols; if (t == 0) sc = scale0; }
        const int col0 = colt + wc * 32 + 8 * fq, bcol0 = u.pn * BM + wc * 32 + 8 * fq;
        f32x4 bv[2][2];
#pragma unroll
        for (int bj = 0; bj < 2; ++bj)
#pragma unroll
            for (int n = 0; n < 2; ++n) bv[bj][n] = bias ? *(const f32x4*)(bias + bcol0 + bj * HALF + 4 * n) : (f32x4){0.f, 0.f, 0.f, 0.f};
#pragma unroll
        for (int ai = 0; ai < 2; ++ai)
#pragma unroll
            for (int m = 0; m < 4; ++m) { bf16_t* rowp = base + (size_t)(row0 + ai * HALF + m * 16) * ldc + col0;
#pragma unroll
                for (int bj = 0; bj < 2; ++bj) { f32x4 v0 = acc[ai][bj][m][0] + bv[bj][0], v1 = acc[ai][bj][m][1] + bv[bj][1];
                    if (ACT == 1) { f32x2 a = gelu_pk((f32x2){v0[0], v0[1]}), b = gelu_pk((f32x2){v0[2], v0[3]}), c = gelu_pk((f32x2){v1[0], v1[1]}), d = gelu_pk((f32x2){v1[2], v1[3]});
                        v0 = (f32x4){a.x, a.y, b.x, b.y}; v1 = (f32x4){c.x, c.y, d.x, d.y}; }
                    v0 = v0 * sc; v1 = v1 * sc; u32x4 w; w.x = cvt_pk_bf16(v0[0], v0[1]); w.y = cvt_pk_bf16(v0[2], v0[3]); w.z = cvt_pk_bf16(v1[0], v1[1]); w.w = cvt_pk_bf16(v1[2], v1[3]);
                    *(u32x4*)(rowp + bj * HALF) = w; } }
    }
};

template <class Epi, class Sched, bool ALIGN_EPI = false, bool SP2 = false>
__device__ __forceinline__ void gemm_phase(PG8_LAS unsigned char* lds, const Gemm g, const Sched& S, const Epi& E, const int wvs) {
    int tid = wvs * 64 + (int)__builtin_amdgcn_mbcnt_hi(~0u, __builtin_amdgcn_mbcnt_lo(~0u, 0u)); asm volatile("" : "+v"(tid)); const int wid = __builtin_amdgcn_readfirstlane(tid >> 6), lane = tid & 63, wr = wid >> 2, wc = wid & 3, fr = lane & 15, fq = lane >> 4;
    const int K = g.K, nt = K / BK;
    unsigned voffA[2], voffB[2];
#pragma unroll
    for (int i = 0; i < 2; ++i) { int R, C; stage_rc(tid * 16 + i * 8192, R, C); const int Rb = Epi::PERM ? ((R & ~31) + perm32(R & 31)) : R;
        voffA[i] = (unsigned)(R * K + C) * 2u; voffB[i] = (unsigned)(Rb * K + C) * 2u; }
    const size_t kstep = (size_t)(BK * 2);
    const size_t hstep = (size_t)HALF * K * 2;
    const size_t tstep = 2 * hstep;
    const unsigned ldsw = (unsigned)wid * 1024u;
    const int aoff = lds_byte(wr * 64 + fr, fq * 8), boff = lds_byte(wc * 32 + fr, fq * 8);
#define PG8_SA(b, h) (((b) * 2 + (h)) * HTB)
#define PG8_SB(b, h) ((4 + (b) * 2 + (h)) * HTB)
#define PG8_STAGE(bufoff, gbase, voff) do { _Pragma("unroll") for (int _i = 0; _i < 2; ++_i) \
        __builtin_amdgcn_global_load_lds((const unsigned*)((const char*)(gbase) + (voff)[_i]), (PG8_LAS unsigned*)(lds + (bufoff) + ldsw + _i * 8192), 16, 0, 0); } while (0)
#define PG8_LDA(dst, b, h) do { _Pragma("unroll") for (int m = 0; m < 4; ++m) _Pragma("unroll") for (int k = 0; k < 2; ++k) dst[m][k] = *(const PG8_LAS bf16x8*)(lds + PG8_SA(b, h) + aoff + m * 2048 + k * 1024); } while (0)
#define PG8_LDB(dst, b, h) do { _Pragma("unroll") for (int n = 0; n < 2; ++n) _Pragma("unroll") for (int k = 0; k < 2; ++k) dst[n][k] = *(const PG8_LAS bf16x8*)(lds + PG8_SB(b, h) + boff + n * 2048 + k * 1024); } while (0)
#define PG8_MMA(ai, bj, At, Bt) do { __builtin_amdgcn_s_setprio(1); _Pragma("unroll") for (int m = 0; m < 4; ++m) _Pragma("unroll") for (int n = 0; n < 2; ++n) _Pragma("unroll") for (int k = 0; k < 2; ++k) \
        acc[ai][bj][m][n] = __builtin_amdgcn_mfma_f32_16x16x32_bf16(Bt[n][k], At[m][k], acc[ai][bj][m][n], 0, 0, 0); __builtin_amdgcn_s_setprio(0); } while (0)
#define PG8_WAIT_V(n) asm volatile("s_waitcnt vmcnt(" #n ")" ::: "memory")
#define PG8_WAIT_L(n) asm volatile("s_waitcnt lgkmcnt(" #n ")" ::: "memory")
#define PG8_BAR __builtin_amdgcn_s_barrier()
#define PG8_SCHED __builtin_amdgcn_sched_barrier(0)
    Unit cur, nxt; int ui = 0;
    if (!S.next(0, cur)) return;
    f32x4 acc[2][2][4][2];
#pragma unroll
    for (int a = 0; a < 2; ++a)
#pragma unroll
        for (int b = 0; b < 2; ++b)
#pragma unroll
            for (int m = 0; m < 4; ++m)
#pragma unroll
                for (int n = 0; n < 2; ++n) acc[a][b][m][n] = (f32x4){0.f, 0.f, 0.f, 0.f};
    bf16x8 At[4][2], B0[2][2], B1[2][2];
    const char* cA = (const char*)(cur.w ? g.A2 : g.A) + (size_t)cur.pm * tstep; const char* cB = (const char*)(cur.w ? g.Bt2 : g.Bt) + (size_t)cur.pn * tstep;
    S.a_ready(cur);
    if constexpr (SP2) {
        PG8_STAGE(PG8_SB(0, 0), cB, voffB); PG8_STAGE(PG8_SB(0, 1), cB + hstep, voffB); PG8_STAGE(PG8_SA(0, 0), cA, voffA); PG8_STAGE(PG8_SA(0, 1), cA + hstep, voffA);
        if (wr == 1) PG8_BAR;
        PG8_WAIT_V(2); PG8_BAR;
        PG8_STAGE(PG8_SB(1, 0), cB + kstep, voffB); PG8_STAGE(PG8_SA(1, 0), cA + kstep, voffA); PG8_STAGE(PG8_SB(1, 1), cB + hstep + kstep, voffB);
        PG8_WAIT_V(6); PG8_BAR;
    } else {
        PG8_STAGE(PG8_SB(0, 0), cB, voffB); PG8_STAGE(PG8_SA(0, 0), cA, voffA); PG8_STAGE(PG8_SB(0, 1), cB + hstep, voffB); PG8_STAGE(PG8_SA(0, 1), cA + hstep, voffA);
        if (wr == 1) PG8_BAR;
        PG8_WAIT_V(4); PG8_BAR;
        PG8_STAGE(PG8_SB(1, 0), cB + kstep, voffB); PG8_STAGE(PG8_SA(1, 0), cA + kstep, voffA); PG8_STAGE(PG8_SB(1, 1), cB + hstep + kstep, voffB);
        PG8_WAIT_V(6); PG8_BAR;
    }
    for (;;) {
        const bool has_next = S.next(ui + 1, nxt);
        const char* nA = has_next ? (const char*)(nxt.w ? g.A2 : g.A) + (size_t)nxt.pm * tstep : cA; const char* nB = has_next ? (const char*)(nxt.w ? g.Bt2 : g.Bt) + (size_t)nxt.pn * tstep : cB;
        for (int t = 0; t < nt; t += 2) {
            const bool last = (t == nt - 2);
            const char* a1 = cA + (size_t)(t + 1) * kstep;
            const char* a2 = last ? nA : cA + (size_t)(t + 2) * kstep; const char* b2 = last ? nB : cB + (size_t)(t + 2) * kstep;
            const char* a3 = a2 + kstep; const char* b3 = b2 + kstep;
            if (last && has_next) S.a_ready(nxt);
            if constexpr (SP2) {
            PG8_LDB(B0, 0, 0); PG8_LDB(B1, 0, 1); PG8_SCHED; PG8_LDA(At, 0, 0); PG8_STAGE(PG8_SA(1, 1), a1 + hstep, voffA);
            PG8_WAIT_V(8); PG8_WAIT_L(0); PG8_BAR; PG8_MMA(0, 0, At, B0); PG8_MMA(0, 1, At, B1); PG8_BAR; PG8_SCHED;
            PG8_LDA(At, 0, 1); PG8_STAGE(PG8_SB(0, 0), b2, voffB); PG8_STAGE(PG8_SB(0, 1), b2 + hstep, voffB); PG8_STAGE(PG8_SA(0, 0), a2, voffA);
            PG8_WAIT_V(8); PG8_WAIT_L(0); PG8_BAR; PG8_MMA(1, 0, At, B0); PG8_MMA(1, 1, At, B1); PG8_BAR; PG8_SCHED;
            PG8_LDB(B0, 1, 0); PG8_LDB(B1, 1, 1); PG8_SCHED; PG8_LDA(At, 1, 0); PG8_STAGE(PG8_SA(0, 1), a2 + hstep, voffA);
            PG8_WAIT_V(8); PG8_WAIT_L(0); PG8_BAR; PG8_MMA(0, 0, At, B0); PG8_MMA(0, 1, At, B1); PG8_BAR; PG8_SCHED;
            PG8_LDA(At, 1, 1); PG8_STAGE(PG8_SB(1, 0), b3, voffB); PG8_STAGE(PG8_SB(1, 1), b3 + hstep, voffB); PG8_STAGE(PG8_SA(1, 0), a3, voffA);
            PG8_WAIT_V(8); PG8_WAIT_L(0); PG8_BAR; PG8_MMA(1, 0, At, B0); PG8_MMA(1, 1, At, B1); PG8_BAR; PG8_SCHED;
            } else {
            PG8_LDB(B0, 0, 0); PG8_SCHED; PG8_LDA(At, 0, 0); PG8_STAGE(PG8_SA(1, 1), a1 + hstep, voffA);
            PG8_WAIT_L(8); PG8_BAR; PG8_WAIT_L(0); PG8_MMA(0, 0, At, B0); PG8_BAR; PG8_SCHED;
            PG8_LDB(B1, 0, 1); PG8_STAGE(PG8_SB(0, 0), b2, voffB);
            PG8_BAR; PG8_WAIT_L(0); PG8_MMA(0, 1, At, B1); PG8_BAR;
            PG8_LDA(At, 0, 1); PG8_STAGE(PG8_SA(0, 0), a2, voffA);
            PG8_BAR; PG8_WAIT_L(0); PG8_MMA(1, 0, At, B0); PG8_BAR; PG8_SCHED;
            PG8_STAGE(PG8_SB(0, 1), b2 + hstep, voffB);
            PG8_WAIT_V(6); PG8_BAR; PG8_MMA(1, 1, At, B1); PG8_BAR;
            PG8_LDB(B0, 1, 0); PG8_SCHED; PG8_LDA(At, 1, 0); PG8_STAGE(PG8_SA(0, 1), a2 + hstep, voffA);
            PG8_WAIT_L(8); PG8_BAR; PG8_WAIT_L(0); PG8_MMA(0, 0, At, B0); PG8_BAR; PG8_SCHED;
            PG8_LDB(B1, 1, 1); PG8_STAGE(PG8_SB(1, 0), b3, voffB);
            PG8_BAR; PG8_WAIT_L(0); PG8_MMA(0, 1, At, B1); PG8_BAR;
            PG8_LDA(At, 1, 1); PG8_STAGE(PG8_SA(1, 0), a3, voffA);
            PG8_BAR; PG8_WAIT_L(0); PG8_MMA(1, 0, At, B0); PG8_BAR; PG8_SCHED;
            PG8_STAGE(PG8_SB(1, 1), b3 + hstep, voffB);
            PG8_WAIT_V(6); PG8_BAR; PG8_MMA(1, 1, At, B1); PG8_BAR;
            }
        }
        if constexpr (ALIGN_EPI) { if (wr == 0) PG8_BAR; }
        if constexpr (!Epi::AFTER_DRAIN) { E(acc, cur, wr, wc, fr, fq); S.done(cur); }
        if (!has_next) break;
#pragma unroll
        for (int a = 0; a < 2; ++a)
#pragma unroll
            for (int b = 0; b < 2; ++b)
#pragma unroll
                for (int m = 0; m < 4; ++m)
#pragma unroll
                    for (int n = 0; n < 2; ++n) acc[a][b][m][n] = (f32x4){0.f, 0.f, 0.f, 0.f};
        cur = nxt; cA = nA; cB = nB; ++ui;
        if constexpr (ALIGN_EPI) { if (wr == 1) PG8_BAR; }
    }
    PG8_WAIT_V(0);
    if constexpr (!ALIGN_EPI) { if (wr == 0) PG8_BAR; }
    PG8_BAR;
    if constexpr (Epi::AFTER_DRAIN) { E.fused(acc, cur, wr, wc, fr, fq, lds, wid, lane); S.done(cur); }
#undef PG8_SA
#undef PG8_SB
#undef PG8_STAGE
#undef PG8_LDA
#undef PG8_LDB
#undef PG8_MMA
#undef PG8_WAIT_V
#undef PG8_WAIT_L
#undef PG8_BAR
#undef PG8_SCHED
}
}
typedef unsigned short bf16_t;
typedef short bf16x8 __attribute__((ext_vector_type(8)));
typedef float f32x4 __attribute__((ext_vector_type(4)));
typedef float f32x16 __attribute__((ext_vector_type(16)));
typedef unsigned u32x4 __attribute__((ext_vector_type(4)));
typedef unsigned u32x2 __attribute__((ext_vector_type(2)));

constexpr int NB = 16, SEQ = 2048, DM = 2048, DEPTH = 4, CTXL = 256;
constexpr int TOKL = NB * SEQ, TOKC = NB * CTXL, TOK = TOKL + TOKC;
constexpr int DIN = 6528, NMAIN = 5120;
constexpr int C_S5 = 0, C_Q = 512, C_K = 1024, C_V = 1152, C_RKV = 1280, C_LORA = 2816, C_GATE = 2944;
constexpr int SRC_HY = 2944, SRC_GATE = 4480;
constexpr int NTHR = 512;
constexpr int LDS_BYTES = 147456;

constexpr size_t WS_TAB = 0;
constexpr size_t WS_BAR = 4096;
constexpr size_t WS_WTMAIN = 4096 + 16384;
constexpr size_t WS_WTHY   = WS_WTMAIN + (size_t)NMAIN * DM * 2;
constexpr size_t WS_WTOUT  = WS_WTHY + (size_t)1536 * DM * 2;
constexpr size_t WS_WTGLU  = WS_WTOUT + (size_t)DM * DM * 2;
constexpr size_t WS_MOD    = WS_WTGLU + (size_t)512 * 512 * 2;
constexpr size_t WS_ROPE   = WS_MOD + (size_t)DEPTH * 17 * 6144 * 4;
constexpr size_t WS_S5LB   = WS_ROPE + 16384;
constexpr size_t WS_S5BB   = WS_S5LB + (size_t)DEPTH * 2 * 32 * 64 * 2 * 4;
constexpr size_t WS_GF     = WS_S5BB + (size_t)DEPTH * 2 * 32 * 64 * 16 * 2 * 4;
constexpr size_t WS_GFC    = WS_GF + (size_t)DEPTH * 2 * 512 * 4096 * 2;
constexpr size_t WS_H      = WS_GFC + (size_t)DEPTH * 2 * 512 * 512 * 2;
constexpr size_t WS_YSF    = WS_H;
constexpr size_t WS_Y1     = WS_H + (size_t)TOK * 512 * 4;
constexpr size_t WS_YMIX   = WS_H;
constexpr size_t WS_PROJ   = WS_H + (size_t)TOK * DM * 2;
constexpr size_t WS_HYT    = WS_PROJ + (size_t)TOK * NMAIN * 2;
constexpr size_t WS_ZGLU   = WS_HYT;
constexpr size_t WS_YGELU  = WS_HYT + (size_t)1536 * TOK * 2;
constexpr size_t WS_YATT   = WS_YGELU + (size_t)TOK * 512 * 2;
constexpr size_t WS_YRW    = WS_YATT + (size_t)TOK * 512 * 2;
constexpr size_t WS_BONUS  = WS_YRW + (size_t)2 * TOK * 512 * 2;
constexpr size_t WS_VMIX   = WS_BONUS + (size_t)2 * TOK * 8 * 4;
constexpr size_t WS_YHYT   = WS_VMIX + (size_t)TOK * 512 * 2;
constexpr size_t WS_XC     = WS_YHYT + (size_t)512 * TOK * 2;
constexpr size_t WS_YSB    = WS_XC + (size_t)TOKC * DM * 4;
constexpr size_t WS_END    = WS_YSB + (size_t)TOK * 512 * 4;
static_assert(WS_END <= 1070000000ull, "workspace budget");

enum { I_X = 0, I_C, I_CTX, I_CCTX, I_NORMG, I_WADA, I_BADA, I_WIN, I_WOUT, I_BRG, I_LRE, I_LIM, I_LSTEP, I_BRE, I_BIM, I_CRE, I_CIM, I_S5D,
       I_GLUW, I_GLUB, I_QG, I_KG, I_SINK, I_MUP, I_MUN, I_W0, I_W2, I_A0, I_A2, I_KK, I_KA, I_RK, I_LNG, I_LNB, I_HCW, I_HCB, I_HW1, I_HB1, I_HF1,
       I_HW2, I_HB2, I_HF2, I_HW3, I_HSKIP, N_IN };

struct Args { const float* in[N_IN]; float* out; unsigned char* ws; };
#define GAS1 __attribute__((address_space(1)))
template <class T> __device__ __forceinline__ T* as_global(T* p) { return (T*)(GAS1 T*)p; }
struct InTab { const float* const* t; __device__ __forceinline__ const float* operator[](int i) const { return (const float*)(((GAS1 const float* GAS1 const*)t)[i]); } };
struct Ctx { InTab in; float* out; unsigned char* ws; };
constexpr size_t WS_TAB_BYTES = 4096;

__device__ __forceinline__ float bf2f(unsigned v) { return __uint_as_float(v << 16); }
__device__ __forceinline__ unsigned f2bf(float f) { unsigned u = __float_as_uint(f); return (u + 0x7fffu + ((u >> 16) & 1u)) >> 16; }
__device__ __forceinline__ unsigned pk2(float lo, float hi) { return f2bf(lo) | (f2bf(hi) << 16); }
__device__ __forceinline__ float bflo(unsigned w) { return __uint_as_float(w << 16); }
__device__ __forceinline__ float bfhi(unsigned w) { return __uint_as_float(w & 0xffff0000u); }
__device__ __forceinline__ int ltid_(int wvs) { int t = wvs * 64 + (int)__builtin_amdgcn_mbcnt_hi(~0u, __builtin_amdgcn_mbcnt_lo(~0u, 0u)); asm volatile("" : "+v"(t)); return t; }
#define ltid() ltid_(wvs)
#define BAR_LDS() asm volatile("s_waitcnt lgkmcnt(0)\n\ts_barrier" ::: "memory")
#define LDS_WAIT() asm volatile("s_waitcnt lgkmcnt(0)" ::: "memory")
template <int CTRL> __device__ __forceinline__ float dppf(float x) { return __builtin_bit_cast(float, __builtin_amdgcn_mov_dpp(__builtin_bit_cast(int, x), CTRL, 0xf, 0xf, true)); }
__device__ __forceinline__ float wave_sum(float v) {
    v += dppf<0xB1>(v); v += dppf<0x4E>(v); v += dppf<0x141>(v); v += dppf<0x140>(v);
    const int iv = __builtin_bit_cast(int, v);
    const float r0 = __builtin_bit_cast(float, __builtin_amdgcn_readlane(iv, 0)), r1 = __builtin_bit_cast(float, __builtin_amdgcn_readlane(iv, 16));
    const float r2 = __builtin_bit_cast(float, __builtin_amdgcn_readlane(iv, 32)), r3 = __builtin_bit_cast(float, __builtin_amdgcn_readlane(iv, 48));
    return (r0 + r1) + (r2 + r3);
}
__device__ __forceinline__ float sum8(float v) { asm("" : "+v"(v)); v += dppf<0xB1>(v); asm("" : "+v"(v)); v += dppf<0x4E>(v); asm("" : "+v"(v)); v += dppf<0x141>(v); return v; }
__device__ __forceinline__ float siluf(float x) { return x / (1.f + __expf(-x)); }
__device__ __forceinline__ float sigmf(float x) { return 1.f / (1.f + __expf(-x)); }

struct EpiResid {
    static constexpr bool PERM = true, AFTER_DRAIN = false;
    const float* xin_l; const float* xin_c; float* xo_l; float* xo_c; const float* modl;
    __device__ __forceinline__ void operator()(const pg8::f32x4 (&acc)[2][2][4][2], const pg8::Unit& u, int wr, int wc, int fr, int fq) const {
        const int row0 = u.pm * 256 + wr * 64 + fr, col0 = u.pn * 256 + wc * 32 + 8 * fq;
#pragma unroll
        for (int ai = 0; ai < 2; ++ai)
#pragma unroll
            for (int m = 0; m < 4; ++m) {
                const int row = row0 + ai * 128 + m * 16;
                const bool lat = row < TOKL;
                const int bidx = lat ? (row >> 11) : 16;
                const float* xi = lat ? xin_l + (size_t)row * DM : xin_c + (size_t)(row - TOKL) * DM;
                float* xo = lat ? xo_l + (size_t)row * DM : xo_c + (size_t)(row - TOKL) * DM;
                const float* gp = modl + bidx * 6144 + 4096;
#pragma unroll
                for (int bj = 0; bj < 2; ++bj) {
                    const int col = col0 + bj * 128;
                    const f32x4 g0 = *(const f32x4*)(gp + col), g1 = *(const f32x4*)(gp + col + 4);
                    const f32x4 x0 = *(const f32x4*)(xi + col), x1 = *(const f32x4*)(xi + col + 4);
                    *(f32x4*)(xo + col) = x0 + g0 * acc[ai][bj][m][0];
                    *(f32x4*)(xo + col + 4) = x1 + g1 * acc[ai][bj][m][1];
                }
            }
    }
};

__device__ __forceinline__ void transpose_item(const float* W, int ld, bf16_t* dst, int K, float* scr, int lane) {
#pragma unroll 8
    for (int i = 0; i < 32; ++i) { const int kk = 2 * i + (lane >> 5); scr[kk * 33 + (lane & 31)] = W[(size_t)kk * ld + (lane & 31)]; }
    LDS_WAIT();
    const int c = lane & 7;
#pragma unroll
    for (int j = 0; j < 4; ++j) {
        const int n = (lane >> 3) + 8 * j; const float* s = scr + (8 * c) * 33 + n;
        u32x4 o; o.x = pk2(s[0], s[33]); o.y = pk2(s[2 * 33], s[3 * 33]); o.z = pk2(s[4 * 33], s[5 * 33]); o.w = pk2(s[6 * 33], s[7 * 33]);
        *(u32x4*)(dst + (size_t)n * K + 8 * c) = o;
    }
    LDS_WAIT();
}

__device__ __forceinline__ void convert_weights(const Ctx& a, const int wvs, unsigned char* lds, int l) {
    const int tid = ltid(), lane = tid & 63, wave = tid >> 6;
    unsigned char* ws = a.ws;
    float* scr = (float*)(lds + wave * 8704);
    const int gw = blockIdx.x * 8 + wave, NGW = gridDim.x * 8;
    constexpr int PER_L = 6528 + 2048 + 128;
    for (int it = gw; it < PER_L; it += NGW) {
        int r = it;
        if (r < 6528) {
            const int kb = r / 204, nb = r % 204, n0 = nb * 32, k0 = kb * 64;
            bf16_t* dst;
            if (n0 < SRC_HY) dst = (bf16_t*)(ws + WS_WTMAIN) + (size_t)n0 * DM;
            else if (n0 < SRC_GATE) dst = (bf16_t*)(ws + WS_WTHY) + (size_t)(n0 - SRC_HY) * DM;
            else dst = (bf16_t*)(ws + WS_WTMAIN) + (size_t)(n0 - SRC_GATE + C_GATE) * DM;
            transpose_item(a.in[I_WIN] + (size_t)l * DM * DIN + (size_t)k0 * DIN + n0, DIN, dst + k0, DM, scr, lane);
        } else if (r < 6528 + 2048) {
            r -= 6528; const int kb = r / 64, nb = r % 64, n0 = nb * 32, k0 = kb * 64;
            transpose_item(a.in[I_WOUT] + (size_t)l * DM * DM + (size_t)k0 * DM + n0, DM, (bf16_t*)(ws + WS_WTOUT) + (size_t)n0 * DM + k0, DM, scr, lane);
        } else {
            r -= 6528 + 2048; const int kb = r / 16, nb = r % 16, n0 = nb * 32, k0 = kb * 64;
            transpose_item(a.in[I_GLUW] + (size_t)l * 512 * 512 + (size_t)k0 * 512 + n0, 512, (bf16_t*)(ws + WS_WTGLU) + (size_t)n0 * 512 + k0, 512, scr, lane);
        }
    }
    for (int i = blockIdx.x * NTHR + tid; i < 32768; i += gridDim.x * NTHR)
        *((u32x4*)((bf16_t*)(ws + WS_WTMAIN) + (size_t)4992 * DM) + i) = (u32x4){0u, 0u, 0u, 0u};
}

__device__ __forceinline__ void phase0(const Ctx& a, const int wvs, unsigned char* lds) {
    const int tid = ltid(), lane = tid & 63, wave = tid >> 6;
    unsigned char* ws = a.ws;
    {
        float* sc = (float*)lds;
        float* part = (float*)(lds + 69632);
        float* mod = (float*)(ws + WS_MOD);
        for (int it = blockIdx.x; it < DEPTH * 96; it += gridDim.x) {
            const int l = it / 96, n0 = (it % 96) * 64;
            float acc[17];
#pragma unroll
            for (int r = 0; r < 17; ++r) acc[r] = 0.f;
            const float* W = a.in[I_WADA] + (size_t)l * DM * 6144 + n0 + lane;
            for (int kh = 0; kh < 2; ++kh) {
                __syncthreads();
                for (int i = tid; i < 17 * 1024; i += NTHR) {
                    const int r = i >> 10, k = i & 1023;
                    const float v = (r < 16) ? a.in[I_C][r * DM + kh * 1024 + k] : a.in[I_CCTX][kh * 1024 + k];
                    sc[i] = siluf(v);
                }
                __syncthreads();
                const int kb = wave * 128;
#pragma unroll 16
                for (int kk = 0; kk < 128; ++kk) {
                    const int k = kb + kk;
                    const float w = W[(size_t)(kh * 1024 + k) * 6144];
#pragma unroll
                    for (int r = 0; r < 17; ++r) acc[r] += sc[r * 1024 + k] * w;
                }
            }
#pragma unroll
            for (int r = 0; r < 17; ++r) part[(wave * 17 + r) * 64 + lane] = acc[r];
            __syncthreads();
            for (int i = tid; i < 17 * 64; i += NTHR) {
                const int r = i >> 6, cl = i & 63;
                float s = 0.f;
#pragma unroll
                for (int w = 0; w < 8; ++w) s += part[(w * 17 + r) * 64 + cl];
                mod[((size_t)l * 17 + r) * 6144 + n0 + cl] = s + a.in[I_BADA][l * 6144 + n0 + cl];
            }
        }
        __syncthreads();
    }
    {
        float* rope = (float*)(ws + WS_ROPE);
        if (blockIdx.x == 0) {
            for (int i = tid; i < 64 * 16; i += NTHR) {
                const int pos = i >> 4, ii = i & 15;
                const float inv = 1.0f / powf(10000.f, (float)ii / 16.f);
                const float ang = (float)pos * inv;
                rope[2 * i] = cosf(ang); rope[2 * i + 1] = sinf(ang);
            }
        }
        float* lbt = (float*)(ws + WS_S5LB); float* bbt = (float*)(ws + WS_S5BB);
        for (int i = blockIdx.x * NTHR + tid; i < DEPTH * 2 * 32 * 64; i += gridDim.x * NTHR) {
            const int pg = i >> 6;
            const float dt = expf(a.in[I_LSTEP][pg]);
            const float lr = a.in[I_LRE][i], li = a.in[I_LIM][i];
            const float mag = expf(lr * dt), lbr = mag * cosf(li * dt), lbi = mag * sinf(li * dt);
            const float den = lr * lr + li * li, nr = lbr - 1.f;
            const float cor = (nr * lr + lbi * li) / den, coi = (lbi * lr - nr * li) / den;
            lbt[2 * i] = lbr; lbt[2 * i + 1] = lbi;
            for (int h = 0; h < 16; ++h) {
                const float x = a.in[I_BRE][(size_t)i * 16 + h], y = a.in[I_BIM][(size_t)i * 16 + h];
                bbt[((size_t)i * 16 + h) * 2] = cor * x - coi * y; bbt[((size_t)i * 16 + h) * 2 + 1] = cor * y + coi * x;
            }
        }
    }
    {
        float* zs = (float*)lds;
        float* h1 = (float*)(lds + 4096);
        float* h2 = (float*)(lds + 8192);
        for (int it = (blockIdx.x + (gridDim.x >> 1)) % gridDim.x; it < DEPTH * 144; it += gridDim.x) {
            const int l = it / 144, r = it % 144;
            const bool isc = r >= 128; const int n = isc ? 256 : 2048; const int p0 = (isc ? r - 128 : r) * 16;
            __syncthreads();
            for (int i = tid; i < 16 * 33; i += NTHR) {
                const int pp = i / 33, e = i % 33; const int pos = p0 + pp;
                float v;
                if (e == 0) v = (float)pos / (float)(n - 1);
                else {
                    const int j = (e - 1) & 15; const float band = 1e-4f + (float)j * ((15.f - 1e-4f) / 15.f);
                    const float ang = 6.283185307179586f * (float)pos / (float)n;
                    v = (e <= 16) ? cosf(band * ang) : -sinf(band * ang);
                }
                zs[i] = v;
            }
            __syncthreads();
            for (int i = tid; i < 16 * 64; i += NTHR) {
                const int pp = i >> 6, uu = i & 63; float s = a.in[I_HB1][l * 64 + uu];
                for (int e = 0; e < 33; ++e) s += zs[pp * 33 + e] * a.in[I_HW1][(l * 33 + e) * 64 + uu];
                h1[i] = sinf(a.in[I_HF1][l * 64 + uu] * s);
            }
            __syncthreads();
            for (int i = tid; i < 16 * 64; i += NTHR) {
                const int pp = i >> 6, uu = i & 63; float s = a.in[I_HB2][l * 64 + uu];
                for (int e = 0; e < 64; ++e) s += h1[pp * 64 + e] * a.in[I_HW2][(l * 64 + e) * 64 + uu];
                h2[i] = sinf(a.in[I_HF2][l * 64 + uu] * s);
            }
            __syncthreads();
            bf16_t* G = isc ? (bf16_t*)(ws + WS_GFC) + (size_t)l * 2 * 512 * 512 : (bf16_t*)(ws + WS_GF) + (size_t)l * 2 * 512 * 4096;
            for (int q = 0; q < 4; ++q) {
                const int col = tid + NTHR * q;
                const int f = col >> 9, c = col & 511, o = f >> 1, bwd = f & 1;
                float acc[16];
#pragma unroll
                for (int pp = 0; pp < 16; ++pp) acc[pp] = 0.f;
                const float* w3 = a.in[I_HW3] + (size_t)l * 64 * 2048 + col;
                for (int e = 0; e < 64; ++e) {
                    const float w = w3[(size_t)e * 2048];
#pragma unroll
                    for (int pp = 0; pp < 16; ++pp) acc[pp] += h2[pp * 64 + e] * w;
                }
                const float lo = -3.0701134573253944f, hi = -15.350567286626972f;
                const float delta = fabsf(lo + (float)c * ((hi - lo) / 511.f));
                bf16_t* Gr = G + ((size_t)o * 512 + c) * (2 * n);
#pragma unroll
                for (int pp = 0; pp < 16; ++pp) {
                    const int pos = p0 + pp; const float t = (float)pos / (float)(n - 1);
                    float v = acc[pp] * expf(-t * delta);
                    if (!bwd) { if (pos == 0) v += a.in[I_HSKIP][(l * 2 + o) * 512 + c]; Gr[n - pos] = (bf16_t)f2bf(v); }
                    else if (pos > 0) Gr[n + pos] = (bf16_t)f2bf(v);
                    else Gr[0] = 0;
                }
            }
        }
        __syncthreads();
    }
}

__device__ __forceinline__ void norm_phase(const Ctx& a, const int wvs, int l) {
    const int tid = ltid(), lane = tid & 63, wave = tid >> 6;
    const int gw = blockIdx.x * 8 + wave, NGW = gridDim.x * 8;
    const float* xl = (l == 0) ? a.in[I_X] : a.out;
    const float* xc = (l == 0) ? a.in[I_CTX] : (const float*)(a.ws + WS_XC);
    const float* mod = (const float*)(a.ws + WS_MOD) + (size_t)l * 17 * 6144;
    const float* g = a.in[I_NORMG] + l * DM;
    bf16_t* H = (bf16_t*)(a.ws + WS_H);
    for (int row = gw; row < TOK; row += NGW) {
        const bool lat = row < TOKL;
        const float* xr = lat ? xl + (size_t)row * DM : xc + (size_t)(row - TOKL) * DM;
        const float* mr = mod + (lat ? (row >> 11) : 16) * 6144;
        f32x4 v[8]; float ss = 0.f;
#pragma unroll
        for (int j = 0; j < 8; ++j) { v[j] = *((const f32x4*)xr + lane + 64 * j); ss += (v[j].x * v[j].x + v[j].y * v[j].y) + (v[j].z * v[j].z + v[j].w * v[j].w); }
        const float rstd = 1.f / sqrtf(wave_sum(ss) * (1.f / DM) + 1e-6f);
#pragma unroll
        for (int j = 0; j < 8; ++j) {
            const int c = 4 * (lane + 64 * j);
            const f32x4 gg = *(const f32x4*)(g + c), sh = *(const f32x4*)(mr + c), sc = *(const f32x4*)(mr + 2048 + c);
            const f32x4 y = (v[j] * rstd) * gg * (sc + 1.f) + sh;
            u32x2 o; o.x = pk2(y.x, y.y); o.y = pk2(y.z, y.w);
            *(u32x2*)(H + (size_t)row * DM + c) = o;
        }
    }
}
#ifndef REP_HY_MM
#define REP_HY_MM 1
#endif
#ifndef REP_RW_CHAIN
#define REP_RW_CHAIN 1
#endif
#ifndef REP_RW_FEAT
#define REP_RW_FEAT 1
#endif
#ifndef REP_SYNC
#define REP_SYNC 1
#endif
#define GSYNC() do { for (int rs_ = 0; rs_ < REP_SYNC; ++rs_) xcd_barrier(xbar, wvs); } while (0)
#ifndef REP_ATT_STAGE
#define REP_ATT_STAGE 1
#endif
#ifndef REP_ATT_S
#define REP_ATT_S 1
#endif
#ifndef REP_RWKV
#define REP_RWKV 1
#endif
#ifndef REP_S5
#define REP_S5 1
#endif
#ifndef REP_ATT
#define REP_ATT 1
#endif
#ifndef REP_HY
#define REP_HY 1
#endif
#ifndef REP_CONV
#define REP_CONV 1
#endif
#ifndef REP_NORM
#define REP_NORM 1
#endif
#ifndef REP_MERGE
#define REP_MERGE 1
#endif
#ifndef REP_P0
#define REP_P0 1
#endif
#ifndef REP_INPROJ
#define REP_INPROJ 1
#endif
#ifndef REP_GLU
#define REP_GLU 1
#endif
#ifndef REP_HYPROJ
#define REP_HYPROJ 1
#endif
__device__ __forceinline__ float softplusf(float x) { return fmaxf(x, 0.f) + log1pf(expf(-fabsf(x))); }

typedef float f32x2 __attribute__((ext_vector_type(2)));
__device__ __forceinline__ float fsig(float x) { return __builtin_amdgcn_rcpf(1.f + __expf(-x)); }
struct RwChunk { int len, cs, rowbase; };
__device__ __forceinline__ RwChunk rw_chunk(int cc, int b) { RwChunk r; const bool isc = cc < 8; r.len = isc ? CTXL : SEQ; r.cs = isc ? cc : cc - 8; r.rowbase = isc ? TOKL + b * CTXL : b * SEQ; return r; }

__device__ __forceinline__ void rwkv_chain(const Ctx& a, const int wvs, unsigned char* lds, int l, int b, int hd, int di) {
    const int tid = ltid(), lane = tid & 63, wave = __builtin_amdgcn_readfirstlane(tid >> 6);
    float* IN = (float*)lds;
    float* YS = (float*)(lds + 98304);
    const bf16_t* proj = (const bf16_t*)(a.ws + WS_PROJ);
    __syncthreads();
    if (wave < 4) {
        f32x2 S0[4], S1[4];
#pragma unroll
        for (int j = 0; j < 4; ++j) { S0[j] = (f32x2){0.f, 0.f}; S1[j] = (f32x2){0.f, 0.f}; }
        const int i2 = tid >> 3, so = tid & 7;
#pragma unroll 1
        for (int k = 0; k < 74; ++k) {
            if (k >= 1 && k <= 72) {
                const float* INb = IN + ((k - 1) & 1) * 12288; float* YSb = YS + ((k - 1) & 1) * 2048;
#define RW_LD(tt_, P) do { const float* q_ = INb + (tt_) * 384 + 8 * so; P##ka = *(const f32x4*)(q_ + 256); P##kb = *(const f32x4*)(q_ + 260); P##wa = *(const f32x4*)(q_ + 64); P##wb = *(const f32x4*)(q_ + 68); \
                    P##ba = *(const f32x4*)(q_ + 320); P##bb = *(const f32x4*)(q_ + 324); P##da = *(const f32x4*)(q_ + 128); P##db = *(const f32x4*)(q_ + 132); P##ra = *(const f32x4*)(q_); P##rb = *(const f32x4*)(q_ + 4); \
                    P##v2 = *(const f32x2*)(INb + (tt_) * 384 + 192 + 2 * i2); } while (0)
#define RW_STEP(tt_, P) do { \
                    f32x2 t0 = S0[0] * P##ka.xy, t1 = S1[0] * P##ka.xy; \
                    t0 += S0[1] * P##ka.zw; t1 += S1[1] * P##ka.zw; t0 += S0[2] * P##kb.xy; t1 += S1[2] * P##kb.xy; t0 += S0[3] * P##kb.zw; t1 += S1[3] * P##kb.zw; \
                    const float sa0 = -sum8(t0.x + t0.y), sa1 = -sum8(t1.x + t1.y); \
                    const f32x2 s0v = {sa0, sa0}, s1v = {sa1, sa1}, v0v = {P##v2.x, P##v2.x}, v1v = {P##v2.y, P##v2.y}; \
                    S0[0] = S0[0] * P##wa.xy + (s0v * P##ba.xy + v0v * P##da.xy); S1[0] = S1[0] * P##wa.xy + (s1v * P##ba.xy + v1v * P##da.xy); \
                    S0[1] = S0[1] * P##wa.zw + (s0v * P##ba.zw + v0v * P##da.zw); S1[1] = S1[1] * P##wa.zw + (s1v * P##ba.zw + v1v * P##da.zw); \
                    S0[2] = S0[2] * P##wb.xy + (s0v * P##bb.xy + v0v * P##db.xy); S1[2] = S1[2] * P##wb.xy + (s1v * P##bb.xy + v1v * P##db.xy); \
                    S0[3] = S0[3] * P##wb.zw + (s0v * P##bb.zw + v0v * P##db.zw); S1[3] = S1[3] * P##wb.zw + (s1v * P##bb.zw + v1v * P##db.zw); \
                    f32x2 y0 = S0[0] * P##ra.xy, y1 = S1[0] * P##ra.xy; \
                    y0 += S0[1] * P##ra.zw; y1 += S1[1] * P##ra.zw; y0 += S0[2] * P##rb.xy; y1 += S1[2] * P##rb.xy; y0 += S0[3] * P##rb.zw; y1 += S1[3] * P##rb.zw; \
                    const float ys0 = sum8(y0.x + y0.y), ys1 = sum8(y1.x + y1.y); \
                    *(f32x2*)(YSb + (tt_) * 64 + 2 * i2) = (f32x2){ys0, ys1}; } while (0)
                f32x4 Aka, Akb, Awa, Awb, Aba, Abb, Ada, Adb, Ara, Arb; f32x2 Av2;
                f32x4 Bka, Bkb, Bwa, Bwb, Bba, Bbb, Bda, Bdb, Bra, Brb; f32x2 Bv2;
                f32x2 Sv0[4], Sv1[4];
#pragma unroll
                for (int j = 0; j < 4; ++j) { Sv0[j] = S0[j]; Sv1[j] = S1[j]; }
                for (int rep_ = 0; rep_ < REP_RW_CHAIN; ++rep_) {
#pragma unroll
                for (int j = 0; j < 4; ++j) { S0[j] = Sv0[j]; S1[j] = Sv1[j]; }
                RW_LD(0, A);
#pragma unroll 1
                for (int tt = 0; tt < 32; tt += 2) {
                    RW_LD(tt + 1, B);
                    RW_STEP(tt, A);
                    RW_LD((tt + 2) & 31, A);
                    RW_STEP(tt + 1, B);
                }
                }
#undef RW_LD
#undef RW_STEP
            }
            BAR_LDS();
        }
    } else {
        const int fw = wave - 4, ch = hd * 64 + lane;
        float* LWA = (float*)(lds + 114688) + fw * 512;
        bf16_t* yrw = (bf16_t*)(a.ws + WS_YRW) + (size_t)di * TOK * 512;
        float* bonus = (float*)(a.ws + WS_BONUS) + (size_t)di * TOK * 8;
        bf16_t* vmix = (bf16_t*)(a.ws + WS_VMIX);
        const float* mup = a.in[I_MUP] + l * 1664; const float* mun = a.in[I_MUN] + l * 1664;
        f32x2 w2p[16], a2p[16];
#pragma unroll
        for (int m = 0; m < 16; ++m) {
            w2p[m] = (f32x2){a.in[I_W2][(((size_t)l * 2 + di) * 32 + 2 * m) * 512 + ch], a.in[I_W2][(((size_t)l * 2 + di) * 32 + 2 * m + 1) * 512 + ch]};
            a2p[m] = (f32x2){a.in[I_A2][(((size_t)l * 2 + di) * 32 + 2 * m) * 512 + ch], a.in[I_A2][(((size_t)l * 2 + di) * 32 + 2 * m + 1) * 512 + ch]};
        }
        const float f_w0 = a.in[I_W0][(l * 2 + di) * 512 + ch], f_a0 = a.in[I_A0][(l * 2 + di) * 512 + ch];
        const float f_kk = a.in[I_KK][l * 512 + ch], f_ka = a.in[I_KA][l * 512 + ch], f_rk = a.in[I_RK][l * 512 + ch];
        const float mp_r = mup[ch], mn_r = mun[ch], mp_k = mup[512 + ch], mn_k = mun[512 + ch], mp_v = mup[1024 + ch], mn_v = mun[1024 + ch];
        const int lc = (lane < 32) ? (di * 32 + lane) : ((2 + di) * 32 + (lane - 32));
        const float mp_l = mup[1536 + lc], mn_l = mun[1536 + lc];
        unsigned short rr[10], rk[10], rv[10], rl[10];
#define RW_LOAD(cc) do { const RwChunk c_ = rw_chunk((cc), b); const int nsc0_ = c_.cs * 32 + 8 * fw; const int plo_ = di ? (c_.len - 1 - nsc0_ - 7) : nsc0_; \
        _Pragma("unroll") for (int j = 0; j < 10; ++j) { const int p_ = plo_ - 1 + j; const bool ok_ = (p_ >= 0) && (p_ < c_.len); \
            const GAS1 bf16_t* pr_ = (const GAS1 bf16_t*)proj + (size_t)(c_.rowbase + (ok_ ? p_ : 0)) * NMAIN; \
            rr[j] = ok_ ? pr_[C_RKV + ch] : (bf16_t)0; rk[j] = ok_ ? pr_[C_RKV + 512 + ch] : (bf16_t)0; rv[j] = ok_ ? pr_[C_RKV + 1024 + ch] : (bf16_t)0; rl[j] = ok_ ? pr_[C_LORA + lc] : (bf16_t)0; } } while (0)
        RW_LOAD(0);
#pragma unroll 1
        for (int k = 0; k < 74; ++k) {
            if (k >= 2) {
                const RwChunk c = rw_chunk(k - 2, b); const float* YSb = YS + ((k - 2) & 1) * 2048;
#pragma unroll
                for (int j = 0; j < 8; ++j) {
                    const int tt = 8 * fw + j, nsc = c.cs * 32 + tt, p = di ? (c.len - 1 - nsc) : nsc;
                    ((GAS1 bf16_t*)yrw)[(size_t)(c.rowbase + p) * 512 + ch] = (bf16_t)f2bf(YSb[tt * 64 + lane]);
                }
            }
            if (k <= 71) {
                const RwChunk c = rw_chunk(k, b); const int nsc0 = c.cs * 32 + 8 * fw; const int plo = di ? (c.len - 1 - nsc0 - 7) : nsc0;
                float zr[8], zk[8], zv[8];
#pragma unroll
                for (int j = 0; j < 8; ++j) {
                    const float r0 = bf2f(rr[j + 1]), k0 = bf2f(rk[j + 1]), v0 = bf2f(rv[j + 1]), l0 = bf2f(rl[j + 1]);
                    zr[j] = r0 + mp_r * (bf2f(rr[j]) - r0) + mn_r * (bf2f(rr[j + 2]) - r0);
                    zk[j] = k0 + mp_k * (bf2f(rk[j]) - k0) + mn_k * (bf2f(rk[j + 2]) - k0);
                    zv[j] = v0 + mp_v * (bf2f(rv[j]) - v0) + mn_v * (bf2f(rv[j + 2]) - v0);
                    const float zl = l0 + mp_l * (bf2f(rl[j]) - l0) + mn_l * (bf2f(rl[j + 2]) - l0);
                    const float th = 1.f - 2.f * __builtin_amdgcn_rcpf(1.f + __expf(2.f * zl));
                    LWA[j * 64 + lane] = (lane < 32) ? th : zl;
                }
                if (k + 1 <= 71) RW_LOAD(k + 1);
                LDS_WAIT();
                float* INb = IN + (k & 1) * 12288;
                for (int rep_ = 0; rep_ < REP_RW_FEAT; ++rep_)
#pragma unroll
                for (int j = 0; j < 8; ++j) {
                    const int tt = di ? (8 * fw + 7 - j) : (8 * fw + j);
                    const int row = c.rowbase + plo + j;
                    const float kkp = zk[j] * f_kk;
                    const float kk = kkp * __builtin_amdgcn_rsqf(wave_sum(kkp * kkp) + 1e-12f);
                    f32x4 lw[8], la[8];
#pragma unroll
                    for (int m4 = 0; m4 < 8; ++m4) { lw[m4] = *(const f32x4*)(LWA + j * 64 + 4 * m4); la[m4] = *(const f32x4*)(LWA + j * 64 + 32 + 4 * m4); }
                    f32x2 wa2 = {f_w0, 0.f}, aa2 = {f_a0, 0.f};
#pragma unroll
                    for (int m4 = 0; m4 < 8; ++m4) {
                        wa2 += lw[m4].xy * w2p[2 * m4]; wa2 += lw[m4].zw * w2p[2 * m4 + 1];
                        aa2 += la[m4].xy * a2p[2 * m4]; aa2 += la[m4].zw * a2p[2 * m4 + 1];
                    }
                    const float wacc = wa2.x + wa2.y, aacc = aa2.x + aa2.y;
                    const float decay = __expf(-0.6065306597126334f * fsig(wacc));
                    const float av = fsig(aacc);
                    const float kd = zk[j] * (1.f + (av - 1.f) * f_ka);
                    const float bsum = wave_sum(zr[j] * kd * f_rk);
                    if (lane == 0) ((GAS1 float*)bonus)[(size_t)row * 8 + hd] = bsum;
                    float* o = INb + tt * 384 + lane;
                    o[0] = zr[j]; o[64] = decay; o[128] = kd; o[192] = zv[j]; o[256] = kk; o[320] = kk * av;
                    if (di == 0) ((GAS1 bf16_t*)vmix)[(size_t)row * 512 + ch] = (bf16_t)f2bf(zv[j]);
                }
            }
            BAR_LDS();
        }
#undef RW_LOAD
    }
    __syncthreads();
}

__device__ __forceinline__ void unpack8(const u32x4 w, float (&v)[8]) {
    v[0] = bflo(w.x); v[1] = bfhi(w.x); v[2] = bflo(w.y); v[3] = bfhi(w.y); v[4] = bflo(w.z); v[5] = bfhi(w.z); v[6] = bflo(w.w); v[7] = bfhi(w.w);
}
__device__ __forceinline__ u32x4 pack8(const float (&v)[8]) { return (u32x4){pk2(v[0], v[1]), pk2(v[2], v[3]), pk2(v[4], v[5]), pk2(v[6], v[7])}; }
__device__ __forceinline__ float gelu_erf(float v) {
    const float av = fabsf(v), t = __builtin_amdgcn_rcpf(av * 0.2316418882f + 1.0f);
    float q = t * 0.5307027145f + (-0.7265760135f); q = q * t + 0.7107068705f; q = q * t + (-0.142248368f); q = q * t + 0.127414796f; q = q * t;
    const float e = __builtin_amdgcn_exp2f((v * v) * (-0.72134752044f));
    const float m = v * (q * e), r = v - m;
    return v < 0.f ? m : r;
}

__device__ __forceinline__ unsigned cvt_pk_bf16f(float lo, float hi) { unsigned r; asm volatile("v_cvt_pk_bf16_f32 %0, %1, %2" : "=v"(r) : "v"(lo), "v"(hi)); return r; }

__device__ __forceinline__ void s5_chain(const Ctx& a, const int wvs, unsigned char* ldsw, int l, int b, int g, int di) {
    const int lane = ltid() & 63;
    float* BU = (float*)ldsw;
    bf16_t* HB = (bf16_t*)(ldsw + 16384);
    const bf16_t* proj = (const bf16_t*)(a.ws + WS_PROJ);
    bf16_t* ys = (bf16_t*)(a.ws + (di ? WS_YSB : WS_YSF));
    const int p1 = lane & 31, hi = lane >> 5, n16 = lane & 15, q4 = lane >> 4;
    const int pg = ((l * 2 + di) * 32 + g);
    const float* lbt = (const float*)(a.ws + WS_S5LB); const float* bbt = (const float*)(a.ws + WS_S5BB);
    bf16x8 Bf[4];
#pragma unroll
    for (int nt = 0; nt < 4; ++nt) {
        const int pp = nt * 16 + (p1 >> 1), im = p1 & 1;
        const float* bp = bbt + (((size_t)pg * 64 + pp) * 16 + 8 * hi) * 2 + im;
        bf16x8 f;
#pragma unroll
        for (int jj = 0; jj < 8; ++jj) f[jj] = (short)f2bf(bp[2 * jj]);
        Bf[nt] = f;
    }
    const float ar = lbt[((size_t)pg * 64 + lane) * 2], ai = lbt[((size_t)pg * 64 + lane) * 2 + 1];
    bf16x8 Cf[4];
#pragma unroll
    for (int ks = 0; ks < 4; ++ks) {
        const int k0 = ks * 32 + 8 * q4;
        const float* cr = a.in[I_CRE] + ((size_t)pg * 16 + n16) * 64 + (k0 >> 1);
        const float* ci = a.in[I_CIM] + ((size_t)pg * 16 + n16) * 64 + (k0 >> 1);
        bf16x8 f;
#pragma unroll
        for (int jj = 0; jj < 4; ++jj) { f[2 * jj] = (short)f2bf(cr[jj]); f[2 * jj + 1] = (short)f2bf(-ci[jj]); }
        Cf[ks] = f;
    }
    float hr = 0.f, him = 0.f;
#define S5_LOADA(ci_, dst) do { const bool isc_ = (ci_) < 8; const int len_ = isc_ ? CTXL : SEQ; const int cs_ = isc_ ? (ci_) : (ci_) - 8; const int rb_ = isc_ ? TOKL + b * CTXL : b * SEQ; \
        const int nsc_ = cs_ * 32 + p1; const int p_ = di ? (len_ - 1 - nsc_) : nsc_; dst = *(const GAS1 bf16x8*)((const GAS1 bf16_t*)proj + (size_t)(rb_ + p_) * NMAIN + C_S5 + g * 16 + 8 * hi); } while (0)
    bf16x8 Anext, Anext2; S5_LOADA(0, Anext); S5_LOADA(1, Anext2);
#pragma unroll 1
    for (int ci = 0; ci < 72; ++ci) {
        const bool isc = ci < 8; const int len = isc ? CTXL : SEQ; const int cs = isc ? ci : ci - 8;
        const int rowbase = isc ? TOKL + b * CTXL : b * SEQ;
        const bf16x8 A = Anext; Anext = Anext2;
        if (ci + 2 < 72) S5_LOADA(ci + 2, Anext2);
#pragma unroll
        for (int nt = 0; nt < 4; ++nt) {
            f32x16 acc;
#pragma unroll
            for (int r = 0; r < 16; ++r) acc[r] = 0.f;
            acc = __builtin_amdgcn_mfma_f32_32x32x16_bf16(A, Bf[nt], acc, 0, 0, 0);
#pragma unroll
            for (int r = 0; r < 16; ++r) BU[(8 * (r >> 2) + 4 * hi + (r & 3)) * 128 + nt * 32 + p1] = acc[r];
        }
        LDS_WAIT();
#pragma unroll 1
        for (int t0 = 0; t0 < 32; t0 += 8) {
            f32x2 bu[8];
#pragma unroll
            for (int k = 0; k < 8; ++k) bu[k] = *(const f32x2*)(BU + (t0 + k) * 128 + 2 * lane);
#pragma unroll
            for (int k = 0; k < 8; ++k) {
                const float nr = ar * hr - ai * him + bu[k].x, ni = ar * him + ai * hr + bu[k].y;
                hr = nr; him = ni;
                *(unsigned*)(HB + (t0 + k) * 136 + 2 * lane) = cvt_pk_bf16f(hr, him);
            }
        }
        LDS_WAIT();
#pragma unroll
        for (int mt = 0; mt < 2; ++mt) {
            f32x4 y = {0.f, 0.f, 0.f, 0.f};
#pragma unroll
            for (int ks = 0; ks < 4; ++ks) {
                const bf16x8 Ah = *(const bf16x8*)(HB + (mt * 16 + n16) * 136 + ks * 32 + 8 * q4);
                y = __builtin_amdgcn_mfma_f32_16x16x32_bf16(Ah, Cf[ks], y, 0, 0, 0);
            }
#pragma unroll
            for (int j = 0; j < 4; ++j) {
                const int nsc = cs * 32 + mt * 16 + 4 * q4 + j; const int p = di ? (len - 1 - nsc) : nsc;
                ((GAS1 bf16_t*)ys)[(size_t)(rowbase + p) * 512 + g * 16 + n16] = (bf16_t)f2bf(y[j]);
            }
        }
        LDS_WAIT();
    }
#undef S5_LOADA
}

__device__ __forceinline__ void s5_combine(const Ctx& a, const int wvs, int l, int pr0) {
    const int tid = ltid();
    const bf16_t* proj = (const bf16_t*)(a.ws + WS_PROJ);
    const bf16_t* yf = (const bf16_t*)(a.ws + WS_YSF); const bf16_t* yb = (const bf16_t*)(a.ws + WS_YSB);
    bf16_t* ygelu = (bf16_t*)(a.ws + WS_YGELU);
#pragma unroll 3
    for (int i = tid; i < 2304 * 4; i += NTHR) {
        const int half = i & 1, pr = pr0 + ((i >> 1) & 1), tok = i >> 2;
        const int b = pr >> 5, g = pr & 31;
        const int row = tok < CTXL ? TOKL + b * CTXL + tok : b * SEQ + (tok - CTXL);
        const size_t idx = (size_t)row * 512 + g * 16 + 8 * half;
        const u32x4 fw = *(const u32x4*)(yf + idx), bw = *(const u32x4*)(yb + idx);
        const u32x4 uw = *(const u32x4*)(proj + (size_t)row * NMAIN + C_S5 + g * 16 + 8 * half);
        const float* dk = a.in[I_S5D] + (l * 32 + g) * 16 + 8 * half;
        float v[8], vb[8]; unpack8(fw, v); unpack8(bw, vb);
#pragma unroll
        for (int e = 0; e < 8; ++e) v[e] += vb[e];
        float u[8]; unpack8(uw, u);
#pragma unroll
        for (int e = 0; e < 8; ++e) v[e] = gelu_erf(v[e] + dk[e] * u[e]);
        *(u32x4*)(ygelu + idx) = pack8(v);
    }
}

__device__ __forceinline__ void attn_unit(const Ctx& a, const int wvs, unsigned char* lds, int l, int b, int hp, int qb, bool qctx) {
    const int tid = ltid(), lane = tid & 63, wave = tid >> 6, n16 = lane & 15, q4 = lane >> 4;
    bf16_t* Ks = (bf16_t*)lds;
    bf16_t* Vt = (bf16_t*)(lds + 18432);
    const bf16_t* proj = (const bf16_t*)(a.ws + WS_PROJ);
    bf16_t* yatt = (bf16_t*)(a.ws + WS_YATT);
    const float* qg = a.in[I_QG] + l * 64; const float* kg = a.in[I_KG] + l * 64;
    const float* rope = (const float*)(a.ws + WS_ROPE);
    const int kvh = hp >> 1;
    const float LOG2E = 1.4426950408889634f;
    const int qi = wave * 16 + n16;
    const int qpos = qb * 128 + qi;
    const int qrow = qctx ? TOKL + b * CTXL + qpos : b * SEQ + qpos;
#define ATT_VALID(t) (((t) >= 3) || (!qctx && (qb - 1 + (t)) >= 0 && (qb - 1 + (t)) <= 15))
#define ATT_KROW0(t) (((t) < 3) ? b * SEQ + (qb - 1 + (t)) * 128 : TOKL + b * CTXL + ((t) - 3) * 128)
    u32x2 kra[2], krb[2]; u32x4 vr[2];
#define ATT_LOAD(t) do { const int kr0_ = ATT_KROW0(t); _Pragma("unroll") for (int i = 0; i < 2; ++i) { const int tk = tid + NTHR * i; const int key = tk >> 3, sub = tk & 7, hf = sub >> 2, aa = sub & 3; \
        const GAS1 bf16_t* kp = (const GAS1 bf16_t*)proj + (size_t)(kr0_ + key) * NMAIN + C_K + kvh * 64 + hf * 32 + 4 * aa; kra[i] = *(const GAS1 u32x2*)kp; krb[i] = *(const GAS1 u32x2*)(kp + 16); \
        vr[i] = *(const GAS1 u32x4*)((const GAS1 bf16_t*)proj + (size_t)(kr0_ + key) * NMAIN + C_V + kvh * 64 + 8 * sub); } } while (0)
    int t = 0;
    while (!ATT_VALID(t)) ++t;
    ATT_LOAD(t);
    bf16x8 Qf[2][2];
    float m[2], lsum[2];
    f32x4 o[2][4];
#pragma unroll
    for (int h2 = 0; h2 < 2; ++h2) {
        const int hq = 2 * hp + h2;
        float va[2][4], vb[2][4]; float ss = 0.f;
#pragma unroll
        for (int hf = 0; hf < 2; ++hf) {
            const bf16_t* qp = proj + (size_t)qrow * NMAIN + C_Q + hq * 64 + hf * 32 + 4 * q4;
            const u32x2 wa = *(const u32x2*)qp, wb = *(const u32x2*)(qp + 16);
            va[hf][0] = bflo(wa.x); va[hf][1] = bfhi(wa.x); va[hf][2] = bflo(wa.y); va[hf][3] = bfhi(wa.y);
            vb[hf][0] = bflo(wb.x); vb[hf][1] = bfhi(wb.x); vb[hf][2] = bflo(wb.y); vb[hf][3] = bfhi(wb.y);
#pragma unroll
            for (int jj = 0; jj < 4; ++jj) ss += va[hf][jj] * va[hf][jj] + vb[hf][jj] * vb[hf][jj];
        }
        ss += __shfl_xor(ss, 16); ss += __shfl_xor(ss, 32);
        const float rstd = __builtin_amdgcn_rsqf(ss * (1.f / 64.f) + 1e-6f);
        const float qs = 0.125f * LOG2E;
#pragma unroll
        for (int hf = 0; hf < 2; ++hf) {
            const int ipos = (hf == 0 ? (qpos >> 6) : (qpos & 63));
            bf16x8 f;
#pragma unroll
            for (int jj = 0; jj < 4; ++jj) {
                const int i = 4 * q4 + jj;
                float u1 = va[hf][jj] * rstd * qg[hf * 32 + i], u2 = vb[hf][jj] * rstd * qg[hf * 32 + 16 + i];
                if (!qctx) {
                    const f32x2 csn = *(const GAS1 f32x2*)((const GAS1 float*)rope + (ipos * 16 + i) * 2);
                    const float o1 = u1 * csn.x - u2 * csn.y, o2 = u2 * csn.x + u1 * csn.y; u1 = o1; u2 = o2;
                }
                f[jj] = (short)f2bf(u1 * qs); f[4 + jj] = (short)f2bf(u2 * qs);
            }
            Qf[h2][hf] = f;
        }
        m[h2] = a.in[I_SINK][l * 8 + hq] * LOG2E; lsum[h2] = (q4 == 0) ? 1.f : 0.f;
#pragma unroll
        for (int i = 0; i < 4; ++i) o[h2][i] = (f32x4){0.f, 0.f, 0.f, 0.f};
    }
    const int vsw0 = ((n16 >> 3) & 1);
#pragma unroll 1
    while (t < 5) {
        int tn = t + 1;
        while (tn < 5 && !ATT_VALID(tn)) ++tn;
        const bool local = t < 3; const int kb = local ? qb - 1 + t : 0;
        BAR_LDS();
#pragma unroll
        for (int i = 0; i < 2; ++i) {
            const int tk = tid + NTHR * i; const int key = tk >> 3, sub = tk & 7, hf = sub >> 2, aa = sub & 3;
            const u32x2 wa = kra[i], wb = krb[i];
            float ua[4] = {bflo(wa.x), bfhi(wa.x), bflo(wa.y), bfhi(wa.y)}, ub[4] = {bflo(wb.x), bfhi(wb.x), bflo(wb.y), bfhi(wb.y)};
            float ss = 0.f;
#pragma unroll
            for (int jj = 0; jj < 4; ++jj) ss += ua[jj] * ua[jj] + ub[jj] * ub[jj];
            ss = sum8(ss);
            const float rstd = __builtin_amdgcn_rsqf(ss * (1.f / 64.f) + 1e-6f);
            const int kpos = kb * 128 + key;
            const int ipos = (hf == 0 ? (kpos >> 6) : (kpos & 63)) & 63;
            unsigned w[4];
            float oa[4], ob[4];
#pragma unroll
            for (int jj = 0; jj < 4; ++jj) {
                const int ii = 4 * aa + jj;
                float u1 = ua[jj] * rstd * ((const GAS1 float*)kg)[hf * 32 + ii], u2 = ub[jj] * rstd * ((const GAS1 float*)kg)[hf * 32 + 16 + ii];
                if (local) {
                    const f32x2 csn = *(const GAS1 f32x2*)((const GAS1 float*)rope + (ipos * 16 + ii) * 2);
                    const float o1 = u1 * csn.x - u2 * csn.y, o2 = u2 * csn.x + u1 * csn.y; u1 = o1; u2 = o2;
                }
                oa[jj] = u1; ob[jj] = u2;
            }
            w[0] = pk2(oa[0], oa[1]); w[1] = pk2(oa[2], oa[3]); w[2] = pk2(ob[0], ob[1]); w[3] = pk2(ob[2], ob[3]);
            *(u32x4*)(Ks + key * 72 + hf * 32 + 8 * aa) = (u32x4){w[0], w[1], w[2], w[3]};
            const u32x4 vv = vr[i];
            bf16_t* vt = Vt + (8 * sub) * 136 + (key ^ (sub << 3));
            vt[0] = (bf16_t)(vv.x & 0xffff); vt[136] = (bf16_t)(vv.x >> 16); vt[2 * 136] = (bf16_t)(vv.y & 0xffff); vt[3 * 136] = (bf16_t)(vv.y >> 16);
            vt[4 * 136] = (bf16_t)(vv.z & 0xffff); vt[5 * 136] = (bf16_t)(vv.z >> 16); vt[6 * 136] = (bf16_t)(vv.w & 0xffff); vt[7 * 136] = (bf16_t)(vv.w >> 16);
        }
        if (tn < 5) ATT_LOAD(tn);
        BAR_LDS();
        f32x4 s[2][8];
        const int dlo = (local && kb == qb - 1) ? wvs : 0;
        const int dhi = (local && kb == qb + 1) ? wvs : 7;
#pragma unroll
        for (int mt = 0; mt < 8; ++mt) {
            if (mt < dlo || mt > dhi) { s[0][mt] = (f32x4){-1e30f, -1e30f, -1e30f, -1e30f}; s[1][mt] = s[0][mt]; }
            else {
            s[0][mt] = (f32x4){0.f, 0.f, 0.f, 0.f}; s[1][mt] = (f32x4){0.f, 0.f, 0.f, 0.f};
#pragma unroll
            for (int hf = 0; hf < 2; ++hf) {
                const bf16x8 A = *(const bf16x8*)(Ks + (mt * 16 + n16) * 72 + hf * 32 + 8 * q4);
                s[0][mt] = __builtin_amdgcn_mfma_f32_16x16x32_bf16(A, Qf[0][hf], s[0][mt], 0, 0, 0);
                s[1][mt] = __builtin_amdgcn_mfma_f32_16x16x32_bf16(A, Qf[1][hf], s[1][mt], 0, 0, 0);
            }
            }
        }
        if (local && kb != qb) {
#pragma unroll
            for (int mt = 0; mt < 8; ++mt)
#pragma unroll
                for (int j = 0; j < 4; ++j) {
                    const int kpos = kb * 128 + mt * 16 + 4 * q4 + j; int df = qpos - kpos; df = df < 0 ? -df : df;
                    if (df > 128) { s[0][mt][j] = -1e30f; s[1][mt][j] = -1e30f; }
                }
        }
#pragma unroll
        for (int h2 = 0; h2 < 2; ++h2) {
            float mx = -3e38f;
#pragma unroll
            for (int mt = 0; mt < 8; ++mt) mx = fmaxf(fmaxf(fmaxf(s[h2][mt][0], s[h2][mt][1]), fmaxf(s[h2][mt][2], s[h2][mt][3])), mx);
            mx = fmaxf(mx, __shfl_xor(mx, 16)); mx = fmaxf(mx, __shfl_xor(mx, 32));
            const float mn = fmaxf(m[h2], mx), alpha = __builtin_amdgcn_exp2f(m[h2] - mn); m[h2] = mn;
            float ps = 0.f;
#pragma unroll
            for (int mt = 0; mt < 8; ++mt) {
                if (mt < dlo || mt > dhi) s[h2][mt] = (f32x4){0.f, 0.f, 0.f, 0.f};
                else {
#pragma unroll
                for (int j = 0; j < 4; ++j) { const float p = __builtin_amdgcn_exp2f(s[h2][mt][j] - mn); s[h2][mt][j] = p; ps += p; }
                }
            }
            lsum[h2] = lsum[h2] * alpha + ps;
#pragma unroll
            for (int i = 0; i < 4; ++i) o[h2][i] = o[h2][i] * alpha;
        }
#pragma unroll
        for (int ks = 0; ks < 4; ++ks) {
            if (2 * ks + 1 < dlo || 2 * ks > dhi) continue;
            bf16x8 Bp[2];
#pragma unroll
            for (int h2 = 0; h2 < 2; ++h2) {
                u32x4 bp;
                bp.x = cvt_pk_bf16f(s[h2][2 * ks][0], s[h2][2 * ks][1]); bp.y = cvt_pk_bf16f(s[h2][2 * ks][2], s[h2][2 * ks][3]);
                bp.z = cvt_pk_bf16f(s[h2][2 * ks + 1][0], s[h2][2 * ks + 1][1]); bp.w = cvt_pk_bf16f(s[h2][2 * ks + 1][2], s[h2][2 * ks + 1][3]);
                Bp[h2] = __builtin_bit_cast(bf16x8, bp);
            }
#pragma unroll
            for (int md = 0; md < 4; ++md) {
                const int sw = ((2 * md + vsw0) & 7) << 3;
                const bf16_t* vrow = Vt + (md * 16 + n16) * 136;
                const u32x2 v0 = *(const u32x2*)(vrow + ((ks * 32 + 4 * q4) ^ sw)), v1 = *(const u32x2*)(vrow + ((ks * 32 + 16 + 4 * q4) ^ sw));
                const bf16x8 av = __builtin_bit_cast(bf16x8, (u32x4){v0.x, v0.y, v1.x, v1.y});
                o[0][md] = __builtin_amdgcn_mfma_f32_16x16x32_bf16(av, Bp[0], o[0][md], 0, 0, 0);
                o[1][md] = __builtin_amdgcn_mfma_f32_16x16x32_bf16(av, Bp[1], o[1][md], 0, 0, 0);
            }
        }
        t = tn;
    }
#undef ATT_VALID
#undef ATT_KROW0
#undef ATT_LOAD
#pragma unroll
    for (int h2 = 0; h2 < 2; ++h2) {
        float ls = lsum[h2];
        ls += __shfl_xor(ls, 16); ls += __shfl_xor(ls, 32);
        const float il = __builtin_amdgcn_rcpf(ls);
#pragma unroll
        for (int md = 0; md < 4; ++md) {
            u32x2 w; w.x = pk2(o[h2][md][0] * il, o[h2][md][1] * il); w.y = pk2(o[h2][md][2] * il, o[h2][md][3] * il);
            *(u32x2*)(yatt + (size_t)qrow * 512 + (2 * hp + h2) * 64 + md * 16 + 4 * q4) = w;
        }
    }
}

__device__ __forceinline__ unsigned fsr16(unsigned lo, unsigned hi) { return __builtin_amdgcn_alignbit(hi, lo, 16); }

__device__ __forceinline__ void hyena_item(const Ctx& a, const int wvs, unsigned char* lds, int l, int c, bool isc) {
    const int tid = ltid(), lane = tid & 63, wave = tid >> 6, n16 = lane & 15, q4 = lane >> 4;
    const int n = isc ? CTXL : SEQ, tokbase = isc ? TOKL : 0, UST = n + 8, GST = 2 * n + 16;
    bf16_t* Ub = (bf16_t*)lds;
    bf16_t* Gs = (bf16_t*)(lds + 16 * UST * 2);
    const bf16_t* hyT = (const bf16_t*)(a.ws + WS_HYT);
    bf16_t* yh = (bf16_t*)(a.ws + WS_YHYT);
    const float* cw = a.in[I_HCW] + (size_t)l * 3 * 1536; const float* cb = a.in[I_HCB] + (size_t)l * 1536;
    u32x2 yst0[8], yst1[8];
#pragma unroll
    for (int r = 0; r < 8; ++r) { yst0[r] = (u32x2){0u, 0u}; yst1[r] = (u32x2){0u, 0u}; }
#pragma unroll 1
    for (int o = 0; o < 2; ++o) {
        BAR_LDS();
        const int n8 = n >> 3;
        u32x4 g0pre;
        {
            const bf16_t* Gp = isc ? (const bf16_t*)(a.ws + WS_GFC) + (((size_t)l * 2 + o) * 512 + c) * 512 : (const bf16_t*)(a.ws + WS_GF) + (((size_t)l * 2 + o) * 512 + c) * 4096;
            g0pre = (tid < 2 * n8) ? *(const u32x4*)(Gp + 8 * tid) : (u32x4){0u, 0u, 0u, 0u};
        }
        if (o == 0) {
            const bf16_t* src = hyT + (size_t)c * TOK + tokbase;
            const float w0 = cw[c], w1 = cw[1536 + c], w2 = cw[3072 + c], bs = cb[c];
#pragma unroll 8
            for (int i = tid; i < 16 * n8; i += NTHR) {
                const int bb = i / n8, t8 = (i - bb * n8) * 8;
                const bf16_t* s = src + bb * n + t8;
                float v[10]; float e[8];
                unpack8(*(const u32x4*)s, e);
                v[0] = t8 > 0 ? bf2f(s[-1]) : 0.f; v[9] = (t8 + 8 < n) ? bf2f(s[8]) : 0.f;
#pragma unroll
                for (int k = 0; k < 8; ++k) v[k + 1] = e[k];
                float r[8];
#pragma unroll
                for (int k = 0; k < 8; ++k) r[k] = w0 * v[k] + w1 * v[k + 1] + w2 * v[k + 2] + bs;
                *(u32x4*)(Ub + bb * UST + t8) = pack8(r);
            }
        } else {
#pragma unroll 1
            for (int gi = 0; gi < 2; ++gi) {
                const int grp = wave + 8 * gi;
                if (grp < (n >> 7)) {
#pragma unroll
                    for (int r = 0; r < 8; ++r) *(u32x2*)(Ub + n16 * UST + 16 * (grp * 8 + r) + 4 * q4) = (gi == 0) ? yst0[r] : yst1[r];
                }
            }
        }
        {
            const bf16_t* G = isc ? (const bf16_t*)(a.ws + WS_GFC) + (((size_t)l * 2 + o) * 512 + c) * 512 : (const bf16_t*)(a.ws + WS_GF) + (((size_t)l * 2 + o) * 512 + c) * 4096;
            const int nch = GST >> 3;
            *(u32x4*)(Gs + 8 * tid) = g0pre;
            for (int m = tid + NTHR; m < nch; m += NTHR) *(u32x4*)(Gs + 8 * m) = (m < 2 * n8) ? *(const u32x4*)(G + 8 * m) : (u32x4){0u, 0u, 0u, 0u};
            BAR_LDS();
            for (int m = tid; m < nch; m += NTHR) {
                const u32x4 hi4 = *(const u32x4*)(Gs + 8 * m);
                const u32x4 lo4 = (m > 0) ? *(const u32x4*)(Gs + 8 * m - 8) : (u32x4){0u, 0u, 0u, 0u};
                const unsigned d[8] = {lo4.x, lo4.y, lo4.z, lo4.w, hi4.x, hi4.y, hi4.z, hi4.w};
#pragma unroll
                for (int k = 1; k < 8; ++k) {
                    u32x4 w;
                    if ((k & 1) == 0) { w.x = d[4 - k / 2]; w.y = d[5 - k / 2]; w.z = d[6 - k / 2]; w.w = d[7 - k / 2]; }
                    else { const int s = (8 - k) >> 1; w.x = fsr16(d[s], d[s + 1]); w.y = fsr16(d[s + 1], d[s + 2]); w.z = fsr16(d[s + 2], d[s + 3]); w.w = (s + 4 < 8) ? fsr16(d[s + 3], d[s + 4]) : 0u; }
                    *(u32x4*)(Gs + k * GST + 8 * m) = w;
                }
            }
        }
        BAR_LDS();
        const int xch = 512 * (o + 1) + c;
        const float xw0 = cw[xch], xw1 = cw[1536 + xch], xw2 = cw[3072 + xch], xbs = cb[xch];
        const bf16_t* xsrc = hyT + (size_t)xch * TOK + tokbase + n16 * n;
        bf16_t* dst = yh + (size_t)c * TOK + tokbase + n16 * n;
        const bf16_t* gl = Gs + (n16 & 7) * GST + n + 8 * q4 - 8 * (n16 >> 3);
        const bf16_t* bbp = Ub + n16 * UST + 8 * q4;
#pragma unroll 1
        for (int gi = 0; gi < 2; ++gi) {
            const int grp = wave + 8 * gi;
            if (grp < (n >> 7)) {
            const int tau0 = grp * 8;
            bf16x8 Af[8]; f32x4 acc[8];
#pragma unroll
            for (int r = 0; r < 8; ++r) acc[r] = (f32x4){0.f, 0.f, 0.f, 0.f};
#pragma unroll
            for (int r = 2; r < 8; ++r) Af[r] = *(const bf16x8*)(gl - 16 * (tau0 + r));
            u32x2 xm[8]; bf16_t xl[8], xr[8];
#pragma unroll
            for (int r = 0; r < 8; ++r) {
                const int tb = 16 * (tau0 + r) + 4 * q4;
                xm[r] = *(const GAS1 u32x2*)((const GAS1 bf16_t*)xsrc + tb);
                xl[r] = (tb > 0) ? ((const GAS1 bf16_t*)xsrc)[tb - 1] : (bf16_t)0;
                xr[r] = (tb + 4 < n) ? ((const GAS1 bf16_t*)xsrc)[tb + 4] : (bf16_t)0;
            }
#pragma unroll 1
            for (int s4 = 0; s4 < (n >> 5); s4 += 4) {
#pragma unroll
                for (int u = 0; u < 4; ++u) {
                    const int sg = s4 + u;
                    Af[(8 - 2 * u) & 7] = *(const bf16x8*)(gl - 16 * (tau0 - 2 * sg));
                    Af[(9 - 2 * u) & 7] = *(const bf16x8*)(gl - 16 * (tau0 - 2 * sg + 1));
                    const bf16x8 B = *(const bf16x8*)(bbp + 32 * sg);
#pragma unroll
                    for (int r = 0; r < 8; ++r) acc[r] = __builtin_amdgcn_mfma_f32_16x16x32_bf16(Af[(r - 2 * u + 8) & 7], B, acc[r], 0, 0, 0);
                }
            }
#pragma unroll
            for (int r = 0; r < 8; ++r) {
                const int tb = 16 * (tau0 + r) + 4 * q4;
                const float xv[6] = {bf2f(xl[r]), bflo(xm[r].x), bfhi(xm[r].x), bflo(xm[r].y), bfhi(xm[r].y), bf2f(xr[r])};
                float rr[4];
#pragma unroll
                for (int j = 0; j < 4; ++j) rr[j] = (xw0 * xv[j] + xw1 * xv[j + 1] + xw2 * xv[j + 2] + xbs) * acc[r][j];
                u32x2 w; w.x = pk2(rr[0], rr[1]); w.y = pk2(rr[2], rr[3]);
                if (o == 0) { yst0[r] = (gi == 0) ? w : yst0[r]; yst1[r] = (gi == 1) ? w : yst1[r]; } else *(GAS1 u32x2*)((GAS1 bf16_t*)dst + tb) = w;
            }
            }
        }
    }
    BAR_LDS();
}


__device__ __forceinline__ void merge_phase(const Ctx& a, const int wvs, unsigned char* lds, int l) {
    const int tid = ltid(), lane = tid & 63, wave = tid >> 6;
    bf16_t* HyS = (bf16_t*)lds;
    const bf16_t* proj = (const bf16_t*)(a.ws + WS_PROJ);
    const bf16_t* ygelu = (const bf16_t*)(a.ws + WS_YGELU); const bf16_t* zglu = (const bf16_t*)(a.ws + WS_ZGLU);
    const bf16_t* yatt = (const bf16_t*)(a.ws + WS_YATT); const bf16_t* yrw = (const bf16_t*)(a.ws + WS_YRW);
    const float* bonus = (const float*)(a.ws + WS_BONUS); const bf16_t* vmix = (const bf16_t*)(a.ws + WS_VMIX);
    const bf16_t* yh = (const bf16_t*)(a.ws + WS_YHYT);
    bf16_t* ymix = (bf16_t*)(a.ws + WS_YMIX);
    const int TR = (l < DEPTH - 1) ? 48 : 64, RW = TR >> 3;
    const int ntile = (l < DEPTH - 1 ? TOK : TOKL) / TR;
    const int c0 = 8 * lane;
    float bg0[8], bg1[8], bg2[8], glb[8], lng[8], lnb[8];
#pragma unroll
    for (int e = 0; e < 8; ++e) {
        bg0[e] = a.in[I_BRG][(l * 3 + 0) * 512 + c0 + e]; bg1[e] = a.in[I_BRG][(l * 3 + 1) * 512 + c0 + e]; bg2[e] = a.in[I_BRG][(l * 3 + 2) * 512 + c0 + e];
        glb[e] = a.in[I_GLUB][l * 512 + c0 + e]; lng[e] = a.in[I_LNG][l * 512 + c0 + e]; lnb[e] = a.in[I_LNB][l * 512 + c0 + e];
    }
#pragma unroll 1
    for (int tile = blockIdx.x; tile < ntile; tile += gridDim.x) {
        const int row0 = tile * TR;
        BAR_LDS();
#pragma unroll
        for (int i = 0; i < 8; ++i) {
            const int tk = tid + NTHR * i; const int c = tk >> 3, rg = tk & 7;
            if (rg >= RW) continue;
            const u32x4 w = *(const u32x4*)(yh + (size_t)c * TOK + row0 + 8 * rg);
            bf16_t* d = HyS + (8 * rg) * 520 + c;
            d[0] = (bf16_t)(w.x & 0xffff); d[520] = (bf16_t)(w.x >> 16); d[2 * 520] = (bf16_t)(w.y & 0xffff); d[3 * 520] = (bf16_t)(w.y >> 16);
            d[4 * 520] = (bf16_t)(w.z & 0xffff); d[5 * 520] = (bf16_t)(w.z >> 16); d[6 * 520] = (bf16_t)(w.w & 0xffff); d[7 * 520] = (bf16_t)(w.w >> 16);
        }
        BAR_LDS();
#pragma unroll 2
        for (int rr = 0; rr < RW; ++rr) {
            const int rl = wave * RW + rr; const size_t row = (size_t)row0 + rl;
            const bf16_t* gp = proj + row * NMAIN + C_GATE + c0;
            const u32x4 L_g0 = *(const u32x4*)gp, L_g1 = *(const u32x4*)(gp + 512), L_g2 = *(const u32x4*)(gp + 1024), L_g3 = *(const u32x4*)(gp + 1536);
            const u32x4 L_yg = *(const u32x4*)(ygelu + row * 512 + c0), L_z = *(const u32x4*)(zglu + row * 512 + c0), L_ya = *(const u32x4*)(yatt + row * 512 + c0);
            const u32x4 L_r0 = *(const u32x4*)(yrw + row * 512 + c0), L_r1 = *(const u32x4*)(yrw + (size_t)TOK * 512 + row * 512 + c0), L_vm = *(const u32x4*)(vmix + row * 512 + c0);
            const int hd = lane >> 3;
            const float bon = bonus[row * 8 + hd] + bonus[(size_t)TOK * 8 + row * 8 + hd];
            const u32x4 L_hy = *(const u32x4*)(HyS + rl * 520 + c0);
            float v[8], g[8], z[8], o0[8], o1[8], o2[8];
            unpack8(L_yg, v); unpack8(L_z, z); unpack8(L_g0, g);
            float ss = 0.f;
#pragma unroll
            for (int e = 0; e < 8; ++e) { v[e] = v[e] * sigmf(z[e] + glb[e]); ss += v[e] * v[e]; }
            float rstd = __builtin_amdgcn_rsqf(wave_sum(ss) * (1.f / 512.f) + 1e-6f);
#pragma unroll
            for (int e = 0; e < 8; ++e) o0[e] = v[e] * rstd * bg0[e] * siluf(g[e]);
            unpack8(L_ya, v); unpack8(L_g1, g);
            ss = 0.f;
#pragma unroll
            for (int e = 0; e < 8; ++e) ss += v[e] * v[e];
            rstd = __builtin_amdgcn_rsqf(wave_sum(ss) * (1.f / 512.f) + 1e-6f);
#pragma unroll
            for (int e = 0; e < 8; ++e) o1[e] = v[e] * rstd * bg1[e] * siluf(g[e]);
            unpack8(L_r0, v); unpack8(L_r1, z); unpack8(L_g2, g);
            float sm = 0.f;
#pragma unroll
            for (int e = 0; e < 8; ++e) { v[e] += z[e]; sm += v[e]; }
            const float mu = sum8(sm) * (1.f / 64.f);
            float sv = 0.f;
#pragma unroll
            for (int e = 0; e < 8; ++e) { v[e] -= mu; sv += v[e] * v[e]; }
            const float rs = __builtin_amdgcn_rsqf(sum8(sv) * (1.f / 64.f) + 64e-5f);
            unpack8(L_vm, z);
#pragma unroll
            for (int e = 0; e < 8; ++e) o2[e] = (v[e] * rs * lng[e] + lnb[e] + bon * z[e]) * siluf(g[e]);
            unpack8(L_hy, v); unpack8(L_g3, g);
            ss = 0.f;
#pragma unroll
            for (int e = 0; e < 8; ++e) ss += v[e] * v[e];
            rstd = __builtin_amdgcn_rsqf(wave_sum(ss) * (1.f / 512.f) + 1e-6f);
#pragma unroll
            for (int e = 0; e < 8; ++e) v[e] = v[e] * rstd * bg2[e] * siluf(g[e]);
            *(u32x4*)(ymix + row * DM + c0) = pack8(o0);
            *(u32x4*)(ymix + row * DM + 512 + c0) = pack8(o1);
            *(u32x4*)(ymix + row * DM + 1024 + c0) = pack8(o2);
            *(u32x4*)(ymix + row * DM + 1536 + c0) = pack8(v);
        }
    }
    __syncthreads();
}

#define LAS __attribute__((address_space(3)))
#define XB_TMO      128
#define XB_XCNT(j)  (256  + 64 * (j))
#define XB_XSUB(j)  (1280 + 64 * (j))
#define XB_XGEN(j)  (2304 + 64 * (j))
#define XB_TOP      3328
#define XB_TOPGEN   3392
#define XCD_BAR_WORDS 3456
#define XB_SPIN_CAP (1u << 22)

__device__ __forceinline__ unsigned xb_ld(unsigned* p)              { return __hip_atomic_load(p, __ATOMIC_RELAXED, __HIP_MEMORY_SCOPE_AGENT); }
__device__ __forceinline__ unsigned xb_add(unsigned* p, unsigned v) { return __hip_atomic_fetch_add(p, v, __ATOMIC_RELAXED, __HIP_MEMORY_SCOPE_AGENT); }
__device__ __forceinline__ unsigned xb_xcc_id() { return (unsigned)__builtin_amdgcn_s_getreg((3 << 11) | 20) & 0xFu; }
#define XB_SPIN(cond, bar) do { unsigned _sp = 0; while (cond) { __builtin_amdgcn_s_sleep(1); \
    if ((++_sp & 255u) == 0u) { if (xb_ld(&(bar)[XB_TMO])) break; if (_sp > XB_SPIN_CAP) { atomicAdd(&(bar)[XB_TMO], 1u); break; } } } } while (0)

struct XcdBarrier {
    unsigned* bar; unsigned x;
    volatile LAS unsigned* st;
};

__device__ __forceinline__ XcdBarrier xcd_barrier_post(unsigned* bar, volatile LAS unsigned* st, const int wvs) {
    XcdBarrier b; b.bar = bar; b.x = xb_xcc_id(); b.st = st;
    if (ltid() == 0) (void)xb_add(&bar[XB_XCNT(b.x)], 1u);
    return b;
}
__device__ __forceinline__ void xcd_barrier_complete(unsigned* bar, unsigned x, unsigned& nloc, unsigned& nx) {
    const unsigned G = gridDim.x * gridDim.y * gridDim.z;
    unsigned sum, cnt, mine, sp = 0u;
    for (;;) {
        sum = 0u; cnt = 0u; mine = 0u;
#pragma unroll
        for (unsigned j = 0; j < 16; ++j) { const unsigned c = xb_ld(&bar[XB_XCNT(j)]); sum += c; cnt += (c > 0u) ? 1u : 0u; mine = (j == x) ? c : mine; }
        if (sum == G) break;
        __builtin_amdgcn_s_sleep(1);
        if ((++sp & 255u) == 0u) { if (xb_ld(&bar[XB_TMO])) break; if (sp > XB_SPIN_CAP) { atomicAdd(&bar[XB_TMO], 1u); break; } }
    }
    nloc = mine > 0u ? mine : 1u; nx = cnt > 0u ? cnt : 1u;
}

__device__ __forceinline__ void xcd_barrier(const XcdBarrier& b, const int wvs) {
    asm volatile("s_waitcnt vmcnt(0)" ::: "memory");
    __syncthreads();
    if (ltid() == 0) {
        unsigned* bar = b.bar;
        __builtin_amdgcn_s_waitcnt(0);
        unsigned nloc = b.st[0], nx = b.st[1];
        if (nloc == 0u) { xcd_barrier_complete(bar, b.x, nloc, nx); b.st[0] = nloc; b.st[1] = nx; }
        const unsigned old = xb_add(&bar[XB_XSUB(b.x)], 1u);
        const unsigned gen = old / nloc;
        if (old + 1u == (gen + 1u) * nloc) {
            __builtin_amdgcn_fence(__ATOMIC_RELEASE, "agent");
            asm volatile("s_waitcnt vmcnt(0)" ::: "memory");
            const unsigned og = xb_add(&bar[XB_TOP], 1u);
            const unsigned tg = og / nx;
            if (og + 1u == (tg + 1u) * nx) xb_add(&bar[XB_TOPGEN], 1u);
            else XB_SPIN(xb_ld(&bar[XB_TOPGEN]) == tg, bar);
            __builtin_amdgcn_fence(__ATOMIC_ACQUIRE, "agent");
            xb_add(&bar[XB_XGEN(b.x)], 1u);
            asm volatile("s_waitcnt vmcnt(0)" ::: "memory");
        } else {
            XB_SPIN(xb_ld(&bar[XB_XGEN(b.x)]) == gen, bar);
            __builtin_amdgcn_fence(__ATOMIC_ACQUIRE, "agent");
            asm volatile("s_waitcnt vmcnt(0)" ::: "memory");
        }
    }
    __syncthreads();
}


__device__ __forceinline__ unsigned char* launder(unsigned char* p) { GAS1 unsigned char* q = (GAS1 unsigned char*)p; asm volatile("" : "+s"(q)); return (unsigned char*)q; }
#define MKCTX() Ctx a; { unsigned char* w_ = as_global(launder(ka.ws)); a.ws = w_; a.in.t = (const float* const*)(w_ + WS_TAB); a.out = (float*)(a.in[N_IN]); }
__global__ void __launch_bounds__(NTHR, 2) fwd_mega(Args ka) {
    extern __shared__ __attribute__((aligned(16))) unsigned char lds[];
    const int wvs = __builtin_amdgcn_readfirstlane((int)threadIdx.x >> 6);
    const int tid = ltid();
    const int G = gridDim.x, bid = blockIdx.x;
    PG8_LAS unsigned char* glds = (PG8_LAS unsigned char*)lds;
    if (tid == 0) {
        const float** tab = (const float**)(launder(ka.ws) + WS_TAB);
#define TW(i) tab[i] = ka.in[i];
        TW(0) TW(1) TW(2) TW(3) TW(4) TW(5) TW(6) TW(7) TW(8) TW(9) TW(10) TW(11) TW(12) TW(13) TW(14) TW(15) TW(16) TW(17) TW(18) TW(19) TW(20) TW(21)
        TW(22) TW(23) TW(24) TW(25) TW(26) TW(27) TW(28) TW(29) TW(30) TW(31) TW(32) TW(33) TW(34) TW(35) TW(36) TW(37) TW(38) TW(39) TW(40) TW(41) TW(42) TW(43)
#undef TW
        tab[N_IN] = (const float*)ka.out;
        __threadfence();
    }
    volatile LAS unsigned* xst = (volatile LAS unsigned*)((LAS unsigned char*)lds + (LDS_BYTES - 64));
    if (tid < 2) xst[tid] = 0u;
    __syncthreads();
    cg::this_grid().sync();
    XcdBarrier xbar = xcd_barrier_post((unsigned*)(ka.ws + WS_BAR), xst, wvs);
#ifndef NO_P0
    { MKCTX(); for (int rep = 0; rep < REP_P0; ++rep) phase0(a, wvs, lds); }
#endif
    GSYNC();
#pragma unroll 1
    for (int l = 0; l < DEPTH; ++l) {
        const bool ctx_out = l < DEPTH - 1;
#ifndef NO_NORM
        { MKCTX(); for (int rep = 0; rep < REP_CONV; ++rep) convert_weights(a, wvs, lds, l); for (int rep = 0; rep < REP_NORM; ++rep) norm_phase(a, wvs, l); }
#endif
        GSYNC();
        {
            unsigned char* ws = as_global(launder(ka.ws));
            pg8::Gemm g{(const bf16_t*)(ws + WS_H), (const bf16_t*)(ws + WS_WTMAIN), TOK, NMAIN, DM, nullptr, nullptr};
            pg8::StaticOrder S; S.init(TOK, NMAIN, G, bid);
            pg8::EpiBf16<0> E{(bf16_t*)(ws + WS_PROJ), NMAIN, nullptr, 0, 0, 1.f, nullptr, 0};
            for (int rep = 0; rep < REP_INPROJ; ++rep) pg8::gemm_phase<pg8::EpiBf16<0>, pg8::StaticOrder, true, true>(glds, g, S, E, wvs);
        }
        {
            unsigned char* ws = as_global(launder(ka.ws));
            const int ntok = ctx_out ? TOK : TOKL;
            pg8::Gemm g{(const bf16_t*)(ws + WS_WTHY), (const bf16_t*)(ws + WS_H), 1536, ntok, DM, nullptr, nullptr};
            pg8::StaticOrder S; S.init(1536, ntok, G, (bid + (G >> 1)) % G);
            pg8::EpiBf16<0> E{(bf16_t*)(ws + WS_HYT), TOK, nullptr, 0, 0, 1.f, nullptr, 0};
            for (int rep = 0; rep < REP_HYPROJ; ++rep) pg8::gemm_phase<pg8::EpiBf16<0>, pg8::StaticOrder, true, true>(glds, g, S, E, wvs);
        }
        GSYNC();
        {
#ifndef NO_RWKV
        { MKCTX();
        for (int rep = 0; rep < REP_RWKV; ++rep) for (int it = bid; it < 256; it += G) rwkv_chain(a, wvs, lds, l, it >> 4, (it >> 1) & 7, it & 1); }
#endif
#ifndef NO_S5
        { MKCTX();
        for (int rep = 0; rep < REP_S5; ++rep) for (int it = bid; it < 256; it += G) {
            const int wv = wvs;
            if (wv < 4) { const int pr = 2 * it + (wv >> 1); s5_chain(a, wvs, lds + wv * 25088, l, pr >> 5, pr & 31, wv & 1); }
            __builtin_amdgcn_fence(__ATOMIC_RELEASE, "workgroup"); __syncthreads(); __builtin_amdgcn_fence(__ATOMIC_ACQUIRE, "workgroup");
            s5_combine(a, wvs, l, 2 * it);
        } }
#endif
        __syncthreads();
#ifndef NO_ATT
        { MKCTX();
        for (int rep = 0; rep < REP_ATT; ++rep) for (int it = bid; it < 1024 + (ctx_out ? 128 : 0); it += G) {
            if (it < 1024) attn_unit(a, wvs, lds, l, it >> 6, it & 3, (it >> 2) & 15, false);
            else { const int r = it - 1024; attn_unit(a, wvs, lds, l, r >> 3, r & 3, (r >> 2) & 1, true); }
        } }
#endif
        __syncthreads();
#ifndef NO_HY
        { MKCTX();
        for (int rep = 0; rep < REP_HY; ++rep) for (int it = bid; it < 512 * (ctx_out ? 2 : 1); it += G) hyena_item(a, wvs, lds, l, it & 511, it >= 512); }
#endif
        }
        GSYNC();
        {
            unsigned char* ws = as_global(launder(ka.ws));
            const int ntok = ctx_out ? TOK : TOKL;
            pg8::Gemm g{(const bf16_t*)(ws + WS_YGELU), (const bf16_t*)(ws + WS_WTGLU), ntok, 512, 512, nullptr, nullptr};
            pg8::StaticOrder S; S.init(ntok, 512, G, bid);
            pg8::EpiBf16<0> E{(bf16_t*)(ws + WS_ZGLU), 512, nullptr, 0, 0, 1.f, nullptr, 0};
            for (int rep = 0; rep < REP_GLU; ++rep) pg8::gemm_phase<pg8::EpiBf16<0>, pg8::StaticOrder, true, true>(glds, g, S, E, wvs);
        }
        GSYNC();
#ifndef NO_MERGE
        { MKCTX(); for (int rep = 0; rep < REP_MERGE; ++rep) merge_phase(a, wvs, lds, l); }
#endif
        GSYNC();
        {
            MKCTX(); unsigned char* ws = a.ws;
            const int ntok = ctx_out ? TOK : TOKL;
            pg8::Gemm g{(const bf16_t*)(ws + WS_YMIX), (const bf16_t*)(ws + WS_WTOUT), ntok, DM, DM, nullptr, nullptr};
            pg8::StaticOrder S; S.init(ntok, DM, G, bid);
            EpiResid E{l == 0 ? a.in[I_X] : a.out, l == 0 ? a.in[I_CTX] : (const float*)(ws + WS_XC), a.out, (float*)(ws + WS_XC), (const float*)(ws + WS_MOD) + (size_t)l * 17 * 6144};
            pg8::gemm_phase<EpiResid, pg8::StaticOrder, true, true>(glds, g, S, E, wvs);
        }
        GSYNC();
    }
}

extern "C" void kernel_launch(void* const* d_in, const int* in_sizes, int n_in, void* d_out, int out_size, void* d_ws, size_t ws_size, hipStream_t stream) {
    static int grid = 0;
    if (grid == 0) {
        if (n_in != N_IN || ws_size < WS_END) { fprintf(stderr, "kernel_launch: unexpected inputs (n_in %d, ws %zu, need %zu)\n", n_in, ws_size, (size_t)WS_END); grid = -1; return; }
        int dev = 0, cus = 0, per_cu = 0;
        hipGetDevice(&dev);
        hipDeviceGetAttribute(&cus, hipDeviceAttributeMultiprocessorCount, dev);
        if (hipFuncSetAttribute((const void*)fwd_mega, hipFuncAttributeMaxDynamicSharedMemorySize, LDS_BYTES) != hipSuccess) { fprintf(stderr, "kernel_launch: hipFuncSetAttribute failed\n"); grid = -1; return; }
        if (hipOccupancyMaxActiveBlocksPerMultiprocessor(&per_cu, (const void*)fwd_mega, NTHR, LDS_BYTES) != hipSuccess || per_cu < 1) { fprintf(stderr, "kernel_launch: occupancy query says %d\n", per_cu); per_cu = 1; }
        (void)hipGetLastError();
        grid = cus * 1;
    }
    if (grid < 0) return;
    if (hipMemsetAsync((char*)d_ws + WS_BAR, 0, 16384, stream) != hipSuccess) { fprintf(stderr, "kernel_launch: memset failed\n"); return; }
    Args a{};
    for (int i = 0; i < N_IN; ++i) a.in[i] = (const float*)d_in[i];
    a.out = (float*)d_out; a.ws = (unsigned char*)d_ws;
    void* args[] = {&a};
    hipError_t e = hipLaunchCooperativeKernel((const void*)fwd_mega, dim3(grid), dim3(NTHR), args, LDS_BYTES, stream);
    if (e != hipSuccess) fprintf(stderr, "cooperative launch failed: %s (grid %d)\n", hipGetErrorString(e), grid);
}
```

```cpp
#include <hip/hip_runtime.h>
#include <hip/hip_cooperative_groups.h>
#include <cstdio>
#include <cstdint>
namespace cg = cooperative_groups;
namespace pg8 {
#define PG8_LAS __attribute__((address_space(3)))
typedef unsigned short bf16_t;
typedef short bf16x8 __attribute__((ext_vector_type(8)));
typedef float f32x4 __attribute__((ext_vector_type(4)));
typedef unsigned u32x4 __attribute__((ext_vector_type(4)));
constexpr int BM = 256, BK = 64, HALF = 128, HTB = HALF * BK * 2  , STAGE_BYTES = 8 * HTB, NXCD = 8, WGM = 8;

__host__ __device__ __forceinline__ int lds_byte(int r, int c) { const int st = (r >> 4) * 2 + (c >> 5), rr = r & 15, cc = c & 31, ob = rr * 64 + cc * 2; return st * 1024 + (ob ^ (((ob >> 9) & 1) << 5)); }
__host__ __device__ __forceinline__ void stage_rc(int b, int& R, int& C) { const int st = b / 1024, sb = b % 1024, swz = sb ^ (((sb >> 9) & 1) << 5); R = (st >> 1) * 16 + swz / 64; C = (st & 1) * 32 + (swz % 64) / 2; }
__host__ __device__ __forceinline__ int perm32(int rho) { const int n = rho >> 4, i = rho & 15; return 8 * (i >> 2) + 4 * n + (i & 3); }

struct Unit { int pm, pn, w; };
struct Gemm { const bf16_t* A; const bf16_t* Bt; int M, N, K; const bf16_t* A2; const bf16_t* Bt2; };

struct StaticOrder {
    int nM, nN, nwg, G, c;
    __host__ __device__ void init(int M, int N, int G_, int c_) { nM = M / BM; nN = N / BM; nwg = nM * nN; G = G_; c = c_; }
    __host__ __device__ bool next(int i, Unit& u) const {
        const long L = (long)i * G + c; if (L >= nwg) return false;
        int wgid = (int)L; { const int q = nwg / NXCD, r = nwg % NXCD, xcd = wgid % NXCD, off = wgid / NXCD; wgid = (xcd < r ? xcd * (q + 1) : r * (q + 1) + (xcd - r) * q) + off; }
        const int nig = WGM * nN, gid = wgid / nig, fm = gid * WGM, gsz = (nM - fm) < WGM ? (nM - fm) : WGM;
        u.pm = fm + ((wgid % nig) % gsz); u.pn = (wgid % nig) / gsz; u.w = 0; return true;
    }
    __device__ __forceinline__ void a_ready(const Unit&) const {}
    __device__ __forceinline__ void done(const Unit&) const {}
};

struct DualOrder {
    int nM0, nN0, nwg0, nM1, nN1, nwg1, G, c;
    __host__ __device__ void init(int M0, int N0, int M1, int N1, int G_, int c_) { nM0 = M0 / BM; nN0 = N0 / BM; nwg0 = nM0 * nN0; nM1 = M1 / BM; nN1 = N1 / BM; nwg1 = nM1 * nN1; G = G_; c = c_; }
    __host__ __device__ bool next(int i, Unit& u) const {
        long L = (long)i * G + c; if (L >= nwg0 + nwg1) return false;
        const int w = L >= nwg0; if (w) L -= nwg0;
        const int nM = w ? nM1 : nM0, nN = w ? nN1 : nN0, nwg = w ? nwg1 : nwg0;
        int wgid = (int)L; { const int q = nwg / NXCD, r = nwg % NXCD, xcd = wgid % NXCD, off = wgid / NXCD; wgid = (xcd < r ? xcd * (q + 1) : r * (q + 1) + (xcd - r) * q) + off; }
        const int nig = WGM * nN, gid = wgid / nig, fm = gid * WGM, gsz = (nM - fm) < WGM ? (nM - fm) : WGM;
        u.pm = fm + ((wgid % nig) % gsz); u.pn = (wgid % nig) / gsz; u.w = w; return true;
    }
    __device__ __forceinline__ void a_ready(const Unit&) const {}
    __device__ __forceinline__ void done(const Unit&) const {}
};

__device__ __forceinline__ unsigned cvt_pk_bf16(float lo, float hi) { unsigned r; asm volatile("v_cvt_pk_bf16_f32 %0, %1, %2" : "=v"(r) : "v"(lo), "v"(hi)); return r; }
typedef float f32x2 __attribute__((ext_vector_type(2)));
__device__ __forceinline__ f32x2 gelu_pk(f32x2 v) {
    const f32x2 av = __builtin_elementwise_abs(v), d = av * 0.2316418882f + 1.0f;
    f32x2 t; t.x = __builtin_amdgcn_rcpf(d.x); t.y = __builtin_amdgcn_rcpf(d.y);
    f32x2 q = t * 0.5307027145f + (-0.7265760135f); q = q * t + 0.7107068705f; q = q * t + (-0.142248368f); q = q * t + 0.127414796f; q = q * t;
    const f32x2 s = (v * v) * (-0.72134752044f);
    f32x2 e; e.x = __builtin_amdgcn_exp2f(s.x); e.y = __builtin_amdgcn_exp2f(s.y);
    const f32x2 m = v * (q * e), r = v - m;
    f32x2 o; o.x = v.x < 0.f ? m.x : r.x; o.y = v.y < 0.f ? m.y : r.y; return o;
}

template <int ACT  > struct EpiBf16 {
    static constexpr bool PERM = true, AFTER_DRAIN = false; static_assert(ACT == 0 || ACT == 1, "EpiBf16: ACT is 0 (none) or 1 (gelu_pk)");
    bf16_t* O; int ldc; const float* bias; int split_cols; size_t split_stride; float scale0; bf16_t* O2; int ldc2;
    __device__ __forceinline__ void operator()(const f32x4 (&acc)[2][2][4][2], const Unit& u, int wr, int wc, int fr, int fq) const {
        const int row0 = u.pm * BM + wr * 64 + fr; int colt = u.pn * BM; bf16_t* base = u.w ? O2 : O; const int ldc = u.w ? ldc2 : this->ldc;
        float sc = 1.f; if (split_cols) { const int t = colt / split_cols; base += (size_t)t * split_stride; colt -= t * split_cols; if (t == 0) sc = scale0; }
        const int col0 = colt + wc * 32 + 8 * fq, bcol0 = u.pn * BM + wc * 32 + 8 * fq;
        f32x4 bv[2][2];
#pragma unroll
        for (int bj = 0; bj < 2; ++bj)
#pragma unroll
            for (int n = 0; n < 2; ++n) bv[bj][n] = bias ? *(const f32x4*)(bias + bcol0 + bj * HALF + 4 * n) : (f32x4){0.f, 0.f, 0.f, 0.f};
#pragma unroll
        for (int ai = 0; ai < 2; ++ai)
#pragma unroll
            for (int m = 0; m < 4; ++m) { bf16_t* rowp = base + (size_t)(row0 + ai * HALF + m * 16) * ldc + col0;
#pragma unroll
                for (int bj = 0; bj < 2; ++bj) { f32x4 v0 = acc[ai][bj][m][0] + bv[bj][0], v1 = acc[ai][bj][m][1] + bv[bj][1];
                    if (ACT == 1) { f32x2 a = gelu_pk((f32x2){v0[0], v0[1]}), b = gelu_pk((f32x2){v0[2], v0[3]}), c = gelu_pk((f32x2){v1[0], v1[1]}), d = gelu_pk((f32x2){v1[2], v1[3]});
                        v0 = (f32x4){a.x, a.y, b.x, b.y}; v1 = (f32x4){c.x, c.y, d.x, d.y}; }
                    v0 = v0 * sc; v1 = v1 * sc; u32x4 w; w.x = cvt_pk_bf16(v0[0], v0[1]); w.y = cvt_pk_bf16(v0[2], v0[3]); w.z = cvt_pk_bf16(v1[0], v1[1]); w.w = cvt_pk_bf16(v1[2], v1[3]);
                    *(u32x4*)(rowp + bj * HALF) = w; } }
    }
};

template <class Epi, class Sched, bool ALIGN_EPI = false, bool SP2 = false>
__device__ __forceinline__ void gemm_phase(PG8_LAS unsigned char* lds, const Gemm g, const Sched& S, const Epi& E, const int wvs) {
    int tid = wvs * 64 + (int)__builtin_amdgcn_mbcnt_hi(~0u, __builtin_amdgcn_mbcnt_lo(~0u, 0u)); asm volatile("" : "+v"(tid)); const int wid = __builtin_amdgcn_readfirstlane(tid >> 6), lane = tid & 63, wr = wid >> 2, wc = wid & 3, fr = lane & 15, fq = lane >> 4;
    const int K = g.K, nt = K / BK;
    unsigned voffA[2], voffB[2];
#pragma unroll
    for (int i = 0; i < 2; ++i) { int R, C; stage_rc(tid * 16 + i * 8192, R, C); const int Rb = Epi::PERM ? ((R & ~31) + perm32(R & 31)) : R;
        voffA[i] = (unsigned)(R * K + C) * 2u; voffB[i] = (unsigned)(Rb * K + C) * 2u; }
    const size_t kstep = (size_t)(BK * 2);
    const size_t hstep = (size_t)HALF * K * 2;
    const size_t tstep = 2 * hstep;
    const unsigned ldsw = (unsigned)wid * 1024u;
    const int aoff = lds_byte(wr * 64 + fr, fq * 8), boff = lds_byte(wc * 32 + fr, fq * 8);
#define PG8_SA(b, h) (((b) * 2 + (h)) * HTB)
#define PG8_SB(b, h) ((4 + (b) * 2 + (h)) * HTB)
#define PG8_STAGE(bufoff, gbase, voff) do { _Pragma("unroll") for (int _i = 0; _i < 2; ++_i) \
        __builtin_amdgcn_global_load_lds((const unsigned*)((const char*)(gbase) + (voff)[_i]), (PG8_LAS unsigned*)(lds + (bufoff) + ldsw + _i * 8192), 16, 0, 0); } while (0)
#define PG8_LDA(dst, b, h) do { _Pragma("unroll") for (int m = 0; m < 4; ++m) _Pragma("unroll") for (int k = 0; k < 2; ++k) dst[m][k] = *(const PG8_LAS bf16x8*)(lds + PG8_SA(b, h) + aoff + m * 2048 + k * 1024); } while (0)
#define PG8_LDB(dst, b, h) do { _Pragma("unroll") for (int n = 0; n < 2; ++n) _Pragma("unroll") for (int k = 0; k < 2; ++k) dst[n][k] = *(const PG8_LAS bf16x8*)(lds + PG8_SB(b, h) + boff + n * 2048 + k * 1024); } while (0)
#define PG8_MMA(ai, bj, At, Bt) do { __builtin_amdgcn_s_setprio(1); _Pragma("unroll") for (int m = 0; m < 4; ++m) _Pragma("unroll") for (int n = 0; n < 2; ++n) _Pragma("unroll") for (int k = 0; k < 2; ++k) \
        acc[ai][bj][m][n] = __builtin_amdgcn_mfma_f32_16x16x32_bf16(Bt[n][k], At[m][k], acc[ai][bj][m][n], 0, 0, 0); __builtin_amdgcn_s_setprio(0); } while (0)
#define PG8_WAIT_V(n) asm volatile("s_waitcnt vmcnt(" #n ")" ::: "memory")
#define PG8_WAIT_L(n) asm volatile("s_waitcnt lgkmcnt(" #n ")" ::: "memory")
#define PG8_BAR __builtin_amdgcn_s_barrier()
#define PG8_SCHED __builtin_amdgcn_sched_barrier(0)
    Unit cur, nxt; int ui = 0;
    if (!S.next(0, cur)) return;
    f32x4 acc[2][2][4][2];
#pragma unroll
    for (int a = 0; a < 2; ++a)
#pragma unroll
        for (int b = 0; b < 2; ++b)
#pragma unroll
            for (int m = 0; m < 4; ++m)
#pragma unroll
                for (int n = 0; n < 2; ++n) acc[a][b][m][n] = (f32x4){0.f, 0.f, 0.f, 0.f};
    bf16x8 At[4][2], B0[2][2], B1[2][2];
    const char* cA = (const char*)(cur.w ? g.A2 : g.A) + (size_t)cur.pm * tstep; const char* cB = (const char*)(cur.w ? g.Bt2 : g.Bt) + (size_t)cur.pn * tstep;
    S.a_ready(cur);
    if constexpr (SP2) {
        PG8_STAGE(PG8_SB(0, 0), cB, voffB); PG8_STAGE(PG8_SB(0, 1), cB + hstep, voffB); PG8_STAGE(PG8_SA(0, 0), cA, voffA); PG8_STAGE(PG8_SA(0, 1), cA + hstep, voffA);
        if (wr == 1) PG8_BAR;
        PG8_WAIT_V(2); PG8_BAR;
        PG8_STAGE(PG8_SB(1, 0), cB + kstep, voffB); PG8_STAGE(PG8_SA(1, 0), cA + kstep, voffA); PG8_STAGE(PG8_SB(1, 1), cB + hstep + kstep, voffB);
        PG8_WAIT_V(6); PG8_BAR;
    } else {
        PG8_STAGE(PG8_SB(0, 0), cB, voffB); PG8_STAGE(PG8_SA(0, 0), cA, voffA); PG8_STAGE(PG8_SB(0, 1), cB + hstep, voffB); PG8_STAGE(PG8_SA(0, 1), cA + hstep, voffA);
        if (wr == 1) PG8_BAR;
        PG8_WAIT_V(4); PG8_BAR;
        PG8_STAGE(PG8_SB(1, 0), cB + kstep, voffB); PG8_STAGE(PG8_SA(1, 0), cA + kstep, voffA); PG8_STAGE(PG8_SB(1, 1), cB + hstep + kstep, voffB);
        PG8_WAIT_V(6); PG8_BAR;
    }
    for (;;) {
        const bool has_next = S.next(ui + 1, nxt);
        const char* nA = has_next ? (const char*)(nxt.w ? g.A2 : g.A) + (size_t)nxt.pm * tstep : cA; const char* nB = has_next ? (const char*)(nxt.w ? g.Bt2 : g.Bt) + (size_t)nxt.pn * tstep : cB;
        for (int t = 0; t < nt; t += 2) {
            const bool last = (t == nt - 2);
            const char* a1 = cA + (size_t)(t + 1) * kstep;
            const char* a2 = last ? nA : cA + (size_t)(t + 2) * kstep; const char* b2 = last ? nB : cB + (size_t)(t + 2) * kstep;
            const char* a3 = a2 + kstep; const char* b3 = b2 + kstep;
            if (last && has_next) S.a_ready(nxt);
            if constexpr (SP2) {
            PG8_LDB(B0, 0, 0); PG8_LDB(B1, 0, 1); PG8_SCHED; PG8_LDA(At, 0, 0); PG8_STAGE(PG8_SA(1, 1), a1 + hstep, voffA);
            PG8_WAIT_V(8); PG8_WAIT_L(0); PG8_BAR; PG8_MMA(0, 0, At, B0); PG8_MMA(0, 1, At, B1); PG8_BAR; PG8_SCHED;
            PG8_LDA(At, 0, 1); PG8_STAGE(PG8_SB(0, 0), b2, voffB); PG8_STAGE(PG8_SB(0, 1), b2 + hstep, voffB); PG8_STAGE(PG8_SA(0, 0), a2, voffA);
            PG8_WAIT_V(8); PG8_WAIT_L(0); PG8_BAR; PG8_MMA(1, 0, At, B0); PG8_MMA(1, 1, At, B1); PG8_BAR; PG8_SCHED;
            PG8_LDB(B0, 1, 0); PG8_LDB(B1, 1, 1); PG8_SCHED; PG8_LDA(At, 1, 0); PG8_STAGE(PG8_SA(0, 1), a2 + hstep, voffA);
            PG8_WAIT_V(8); PG8_WAIT_L(0); PG8_BAR; PG8_MMA(0, 0, At, B0); PG8_MMA(0, 1, At, B1); PG8_BAR; PG8_SCHED;
            PG8_LDA(At, 1, 1); PG8_STAGE(PG8_SB(1, 0), b3, voffB); PG8_STAGE(PG8_SB(1, 1), b3 + hstep, voffB); PG8_STAGE(PG8_SA(1, 0), a3, voffA);
            PG8_WAIT_V(8); PG8_WAIT_L(0); PG8_BAR; PG8_MMA(1, 0, At, B0); PG8_MMA(1, 1, At, B1); PG8_BAR; PG8_SCHED;
            } else {
            PG8_LDB(B0, 0, 0); PG8_SCHED; PG8_LDA(At, 0, 0); PG8_STAGE(PG8_SA(1, 1), a1 + hstep, voffA);
            PG8_WAIT_L(8); PG8_BAR; PG8_WAIT_L(0); PG8_MMA(0, 0, At, B0); PG8_BAR; PG8_SCHED;
            PG8_LDB(B1, 0, 1); PG8_STAGE(PG8_SB(0, 0), b2, voffB);
            PG8_BAR; PG8_WAIT_L(0); PG8_MMA(0, 1, At, B1); PG8_BAR;
            PG8_LDA(At, 0, 1); PG8_STAGE(PG8_SA(0, 0), a2, voffA);
            PG8_BAR; PG8_WAIT_L(0); PG8_MMA(1, 0, At, B0); PG8_BAR; PG8_SCHED;
            PG8_STAGE(PG8_SB(0, 1), b2 + hstep, voffB);
            PG8_WAIT_V(6); PG8_BAR; PG8_MMA(1, 1, At, B1); PG8_BAR;
            PG8_LDB(B0, 1, 0); PG8_SCHED; PG8_LDA(At, 1, 0); PG8_STAGE(PG8_SA(0, 1), a2 + hstep, voffA);
            PG8_WAIT_L(8); PG8_BAR; PG8_WAIT_L(0); PG8_MMA(0, 0, At, B0); PG8_BAR; PG8_SCHED;
            PG8_LDB(B1, 1, 1); PG8_STAGE(PG8_SB(1, 0), b3, voffB);
            PG8_BAR; PG8_WAIT_L(0); PG8_MMA(0, 1, At, B1); PG8_BAR;
            PG8_LDA(At, 1, 1); PG8_STAGE(PG8_SA(1, 0), a3, voffA);
            PG8_BAR; PG8_WAIT_L(0); PG8_MMA(1, 0, At, B0); PG8_BAR; PG8_SCHED;
            PG8_STAGE(PG8_SB(1, 1), b3 + hstep, voffB);
            PG8_WAIT_V(6); PG8_BAR; PG8_MMA(1, 1, At, B1); PG8_BAR;
            }
        }
        if constexpr (ALIGN_EPI) { if (wr == 0) PG8_BAR; }
        if constexpr (!Epi::AFTER_DRAIN) { E(acc, cur, wr, wc, fr, fq); S.done(cur); }
        if (!has_next) break;
#pragma unroll
        for (int a = 0; a < 2; ++a)
#pragma unroll
            for (int b = 0; b < 2; ++b)
#pragma unroll
                for (int m = 0; m < 4; ++m)
#pragma unroll
                    for (int n = 0; n < 2; ++n) acc[a][b][m][n] = (f32x4){0.f, 0.f, 0.f, 0.f};
        cur = nxt; cA = nA; cB = nB; ++ui;
        if constexpr (ALIGN_EPI) { if (wr == 1) PG8_BAR; }
    }
    PG8_WAIT_V(0);
    if constexpr (!ALIGN_EPI) { if (wr == 0) PG8_BAR; }
    PG8_BAR;
    if constexpr (Epi::AFTER_DRAIN) { E.fused(acc, cur, wr, wc, fr, fq, lds, wid, lane); S.done(cur); }
#undef PG8_SA
#undef PG8_SB
#undef PG8_STAGE
#undef PG8_LDA
#undef PG8_LDB
#undef PG8_MMA
#undef PG8_WAIT_V
#undef PG8_WAIT_L
#undef PG8_BAR
#undef PG8_SCHED
}
}
typedef unsigned short bf16_t;
typedef short bf16x8 __attribute__((ext_vector_type(8)));
typedef float f32x4 __attribute__((ext_vector_type(4)));
typedef float f32x16 __attribute__((ext_vector_type(16)));
typedef unsigned u32x4 __attribute__((ext_vector_type(4)));
typedef unsigned u32x2 __attribute__((ext_vector_type(2)));

constexpr int NB = 16, SEQ = 2048, DM = 2048, DEPTH = 4, CTXL = 256;
constexpr int TOKL = NB * SEQ, TOKC = NB * CTXL, TOK = TOKL + TOKC;
constexpr int DIN = 6528, NMAIN = 5120;
constexpr int C_S5 = 0, C_Q = 512, C_K = 1024, C_V = 1152, C_RKV = 1280, C_LORA = 2816, C_GATE = 2944;
constexpr int SRC_HY = 2944, SRC_GATE = 4480;
constexpr int NTHR = 512;
constexpr int LDS_BYTES = 147456;

constexpr size_t WS_TAB = 0;
constexpr size_t WS_BAR = 4096;
constexpr size_t WS_WTMAIN = 4096 + 16384;
constexpr size_t WS_WTHY   = WS_WTMAIN + (size_t)NMAIN * DM * 2;
constexpr size_t WS_WTOUT  = WS_WTHY + (size_t)1536 * DM * 2;
constexpr size_t WS_WTGLU  = WS_WTOUT + (size_t)DM * DM * 2;
constexpr size_t WS_MOD    = WS_WTGLU + (size_t)512 * 512 * 2;
constexpr size_t WS_ROPE   = WS_MOD + (size_t)DEPTH * 17 * 6144 * 4;
constexpr size_t WS_S5LB   = WS_ROPE + 16384;
constexpr size_t WS_S5BB   = WS_S5LB + (size_t)DEPTH * 2 * 32 * 64 * 2 * 4;
constexpr size_t WS_GF     = WS_S5BB + (size_t)DEPTH * 2 * 32 * 64 * 16 * 2 * 4;
constexpr size_t WS_GFC    = WS_GF + (size_t)DEPTH * 2 * 512 * 4096 * 2;
constexpr size_t WS_H      = WS_GFC + (size_t)DEPTH * 2 * 512 * 512 * 2;
constexpr size_t WS_YSF    = WS_H;
constexpr size_t WS_Y1     = WS_H + (size_t)TOK * 512 * 4;
constexpr size_t WS_YMIX   = WS_H;
constexpr size_t WS_PROJ   = WS_H + (size_t)TOK * DM * 2;
constexpr size_t WS_HYT    = WS_PROJ + (size_t)TOK * NMAIN * 2;
constexpr size_t WS_ZGLU   = WS_HYT;
constexpr size_t WS_YGELU  = WS_HYT + (size_t)1536 * TOK * 2;
constexpr size_t WS_YATT   = WS_YGELU + (size_t)TOK * 512 * 2;
constexpr size_t WS_YRW    = WS_YATT + (size_t)TOK * 512 * 2;
constexpr size_t WS_BONUS  = WS_YRW + (size_t)2 * TOK * 512 * 2;
constexpr size_t WS_VMIX   = WS_BONUS + (size_t)2 * TOK * 8 * 4;
constexpr size_t WS_YHYT   = WS_VMIX + (size_t)TOK * 512 * 2;
constexpr size_t WS_XC     = WS_YHYT + (size_t)512 * TOK * 2;
constexpr size_t WS_YSB    = WS_XC + (size_t)TOKC * DM * 4;
constexpr size_t WS_END    = WS_YSB + (size_t)TOK * 512 * 4;
static_assert(WS_END <= 1070000000ull, "workspace budget");

enum { I_X = 0, I_C, I_CTX, I_CCTX, I_NORMG, I_WADA, I_BADA, I_WIN, I_WOUT, I_BRG, I_LRE, I_LIM, I_LSTEP, I_BRE, I_BIM, I_CRE, I_CIM, I_S5D,
       I_GLUW, I_GLUB, I_QG, I_KG, I_SINK, I_MUP, I_MUN, I_W0, I_W2, I_A0, I_A2, I_KK, I_KA, I_RK, I_LNG, I_LNB, I_HCW, I_HCB, I_HW1, I_HB1, I_HF1,
       I_HW2, I_HB2, I_HF2, I_HW3, I_HSKIP, N_IN };

struct Args { const float* in[N_IN]; float* out; unsigned char* ws; };
#define GAS1 __attribute__((address_space(1)))
template <class T> __device__ __forceinline__ T* as_global(T* p) { return (T*)(GAS1 T*)p; }
struct InTab { const float* const* t; __device__ __forceinline__ const float* operator[](int i) const { return (const float*)(((GAS1 const float* GAS1 const*)t)[i]); } };
struct Ctx { InTab in; float* out; unsigned char* ws; };
constexpr size_t WS_TAB_BYTES = 4096;

__device__ __forceinline__ float bf2f(unsigned v) { return __uint_as_float(v << 16); }
__device__ __forceinline__ unsigned f2bf(float f) { unsigned u = __float_as_uint(f); return (u + 0x7fffu + ((u >> 16) & 1u)) >> 16; }
__device__ __forceinline__ unsigned pk2(float lo, float hi) { return f2bf(lo) | (f2bf(hi) << 16); }
__device__ __forceinline__ float bflo(unsigned w) { return __uint_as_float(w << 16); }
__device__ __forceinline__ float bfhi(unsigned w) { return __uint_as_float(w & 0xffff0000u); }
__device__ __forceinline__ int ltid_(int wvs) { int t = wvs * 64 + (int)__builtin_amdgcn_mbcnt_hi(~0u, __builtin_amdgcn_mbcnt_lo(~0u, 0u)); asm volatile("" : "+v"(t)); return t; }
#define ltid() ltid_(wvs)
#define BAR_LDS() asm volatile("s_waitcnt lgkmcnt(0)\n\ts_barrier" ::: "memory")
#define LDS_WAIT() asm volatile("s_waitcnt lgkmcnt(0)" ::: "memory")
template <int CTRL> __device__ __forceinline__ float dppf(float x) { return __builtin_bit_cast(float, __builtin_amdgcn_mov_dpp(__builtin_bit_cast(int, x), CTRL, 0xf, 0xf, true)); }
__device__ __forceinline__ float wave_sum(float v) {
    v += dppf<0xB1>(v); v += dppf<0x4E>(v); v += dppf<0x141>(v); v += dppf<0x140>(v);
    const int iv = __builtin_bit_cast(int, v);
    const float r0 = __builtin_bit_cast(float, __builtin_amdgcn_readlane(iv, 0)), r1 = __builtin_bit_cast(float, __builtin_amdgcn_readlane(iv, 16));
    const float r2 = __builtin_bit_cast(float, __builtin_amdgcn_readlane(iv, 32)), r3 = __builtin_bit_cast(float, __builtin_amdgcn_readlane(iv, 48));
    return (r0 + r1) + (r2 + r3);
}
__device__ __forceinline__ float sum8(float v) { asm("" : "+v"(v)); v += dppf<0xB1>(v); asm("" : "+v"(v)); v += dppf<0x4E>(v); asm("" : "+v"(v)); v += dppf<0x141>(v); return v; }
__device__ __forceinline__ float siluf(float x) { return x / (1.f + __expf(-x)); }
__device__ __forceinline__ float sigmf(float x) { return 1.f / (1.f + __expf(-x)); }

struct EpiResid {
    static constexpr bool PERM = true, AFTER_DRAIN = false;
    const float* xin_l; const float* xin_c; float* xo_l; float* xo_c; const float* modl;
    __device__ __forceinline__ void operator()(const pg8::f32x4 (&acc)[2][2][4][2], const pg8::Unit& u, int wr, int wc, int fr, int fq) const {
        const int row0 = u.pm * 256 + wr * 64 + fr, col0 = u.pn * 256 + wc * 32 + 8 * fq;
#pragma unroll
        for (int ai = 0; ai < 2; ++ai)
#pragma unroll
            for (int m = 0; m < 4; ++m) {
                const int row = row0 + ai * 128 + m * 16;
                const bool lat = row < TOKL;
                const int bidx = lat ? (row >> 11) : 16;
                const float* xi = lat ? xin_l + (size_t)row * DM : xin_c + (size_t)(row - TOKL) * DM;
                float* xo = lat ? xo_l + (size_t)row * DM : xo_c + (size_t)(row - TOKL) * DM;
                const float* gp = modl + bidx * 6144 + 4096;
#pragma unroll
                for (int bj = 0; bj < 2; ++bj) {
                    const int col = col0 + bj * 128;
                    const f32x4 g0 = *(const f32x4*)(gp + col), g1 = *(const f32x4*)(gp + col + 4);
                    const f32x4 x0 = *(const f32x4*)(xi + col), x1 = *(const f32x4*)(xi + col + 4);
                    *(f32x4*)(xo + col) = x0 + g0 * acc[ai][bj][m][0];
                    *(f32x4*)(xo + col + 4) = x1 + g1 * acc[ai][bj][m][1];
                }
            }
    }
};

__device__ __forceinline__ void transpose_item(const float* W, int ld, bf16_t* dst, int K, float* scr, int lane) {
#pragma unroll 8
    for (int i = 0; i < 32; ++i) { const int kk = 2 * i + (lane >> 5); scr[kk * 33 + (lane & 31)] = W[(size_t)kk * ld + (lane & 31)]; }
    LDS_WAIT();
    const int c = lane & 7;
#pragma unroll
    for (int j = 0; j < 4; ++j) {
        const int n = (lane >> 3) + 8 * j; const float* s = scr + (8 * c) * 33 + n;
        u32x4 o; o.x = pk2(s[0], s[33]); o.y = pk2(s[2 * 33], s[3 * 33]); o.z = pk2(s[4 * 33], s[5 * 33]); o.w = pk2(s[6 * 33], s[7 * 33]);
        *(u32x4*)(dst + (size_t)n * K + 8 * c) = o;
    }
    LDS_WAIT();
}

__device__ __forceinline__ void convert_weights(const Ctx& a, const int wvs, unsigned char* lds, int l) {
    const int tid = ltid(), lane = tid & 63, wave = tid >> 6;
    unsigned char* ws = a.ws;
    float* scr = (float*)(lds + wave * 8704);
    const int gw = blockIdx.x * 8 + wave, NGW = gridDim.x * 8;
    constexpr int PER_L = 6528 + 2048 + 128;
    for (int it = gw; it < PER_L; it += NGW) {
        int r = it;
        if (r < 6528) {
            const int kb = r / 204, nb = r % 204, n0 = nb * 32, k0 = kb * 64;
            bf16_t* dst;
            if (n0 < SRC_HY) dst = (bf16_t*)(ws + WS_WTMAIN) + (size_t)n0 * DM;
            else if (n0 < SRC_GATE) dst = (bf16_t*)(ws + WS_WTHY) + (size_t)(n0 - SRC_HY) * DM;
            else dst = (bf16_t*)(ws + WS_WTMAIN) + (size_t)(n0 - SRC_GATE + C_GATE) * DM;
            transpose_item(a.in[I_WIN] + (size_t)l * DM * DIN + (size_t)k0 * DIN + n0, DIN, dst + k0, DM, scr, lane);
        } else if (r < 6528 + 2048) {
            r -= 6528; const int kb = r / 64, nb = r % 64, n0 = nb * 32, k0 = kb * 64;
            transpose_item(a.in[I_WOUT] + (size_t)l * DM * DM + (size_t)k0 * DM + n0, DM, (bf16_t*)(ws + WS_WTOUT) + (size_t)n0 * DM + k0, DM, scr, lane);
        } else {
            r -= 6528 + 2048; const int kb = r / 16, nb = r % 16, n0 = nb * 32, k0 = kb * 64;
            transpose_item(a.in[I_GLUW] + (size_t)l * 512 * 512 + (size_t)k0 * 512 + n0, 512, (bf16_t*)(ws + WS_WTGLU) + (size_t)n0 * 512 + k0, 512, scr, lane);
        }
    }
    for (int i = blockIdx.x * NTHR + tid; i < 32768; i += gridDim.x * NTHR)
        *((u32x4*)((bf16_t*)(ws + WS_WTMAIN) + (size_t)4992 * DM) + i) = (u32x4){0u, 0u, 0u, 0u};
}

__device__ __forceinline__ void phase0(const Ctx& a, const int wvs, unsigned char* lds) {
    const int tid = ltid(), lane = tid & 63, wave = tid >> 6;
    unsigned char* ws = a.ws;
    {
        float* sc = (float*)lds;
        float* part = (float*)(lds + 69632);
        float* mod = (float*)(ws + WS_MOD);
        for (int it = blockIdx.x; it < DEPTH * 96; it += gridDim.x) {
            const int l = it / 96, n0 = (it % 96) * 64;
            float acc[17];
#pragma unroll
            for (int r = 0; r < 17; ++r) acc[r] = 0.f;
            const float* W = a.in[I_WADA] + (size_t)l * DM * 6144 + n0 + lane;
            for (int kh = 0; kh < 2; ++kh) {
                __syncthreads();
                for (int i = tid; i < 17 * 1024; i += NTHR) {
                    const int r = i >> 10, k = i & 1023;
                    const float v = (r < 16) ? a.in[I_C][r * DM + kh * 1024 + k] : a.in[I_CCTX][kh * 1024 + k];
                    sc[i] = siluf(v);
                }
                __syncthreads();
                const int kb = wave * 128;
#pragma unroll 16
                for (int kk = 0; kk < 128; ++kk) {
                    const int k = kb + kk;
                    const float w = W[(size_t)(kh * 1024 + k) * 6144];
#pragma unroll
                    for (int r = 0; r < 17; ++r) acc[r] += sc[r * 1024 + k] * w;
                }
            }
#pragma unroll
            for (int r = 0; r < 17; ++r) part[(wave * 17 + r) * 64 + lane] = acc[r];
            __syncthreads();
            for (int i = tid; i < 17 * 64; i += NTHR) {
                const int r = i >> 6, cl = i & 63;
                float s = 0.f;
#pragma unroll
                for (int w = 0; w < 8; ++w) s += part[(w * 17 + r) * 64 + cl];
                mod[((size_t)l * 17 + r) * 6144 + n0 + cl] = s + a.in[I_BADA][l * 6144 + n0 + cl];
            }
        }
        __syncthreads();
    }
    {
        float* rope = (float*)(ws + WS_ROPE);
        if (blockIdx.x == 0) {
            for (int i = tid; i < 64 * 16; i += NTHR) {
                const int pos = i >> 4, ii = i & 15;
                const float inv = 1.0f / powf(10000.f, (float)ii / 16.f);
                const float ang = (float)pos * inv;
                rope[2 * i] = cosf(ang); rope[2 * i + 1] = sinf(ang);
            }
        }
        float* lbt = (float*)(ws + WS_S5LB); float* bbt = (float*)(ws + WS_S5BB);
        for (int i = blockIdx.x * NTHR + tid; i < DEPTH * 2 * 32 * 64; i += gridDim.x * NTHR) {
            const int pg = i >> 6;
            const float dt = expf(a.in[I_LSTEP][pg]);
            const float lr = a.in[I_LRE][i], li = a.in[I_LIM][i];
            const float mag = expf(lr * dt), lbr = mag * cosf(li * dt), lbi = mag * sinf(li * dt);
            const float den = lr * lr + li * li, nr = lbr - 1.f;
            const float cor = (nr * lr + lbi * li) / den, coi = (lbi * lr - nr * li) / den;
            lbt[2 * i] = lbr; lbt[2 * i + 1] = lbi;
            for (int h = 0; h < 16; ++h) {
                const float x = a.in[I_BRE][(size_t)i * 16 + h], y = a.in[I_BIM][(size_t)i * 16 + h];
                bbt[((size_t)i * 16 + h) * 2] = cor * x - coi * y; bbt[((size_t)i * 16 + h) * 2 + 1] = cor * y + coi * x;
            }
        }
    }
    {
        float* zs = (float*)lds;
        float* h1 = (float*)(lds + 4096);
        float* h2 = (float*)(lds + 8192);
        for (int it = (blockIdx.x + (gridDim.x >> 1)) % gridDim.x; it < DEPTH * 144; it += gridDim.x) {
            const int l = it / 144, r = it % 144;
            const bool isc = r >= 128; const int n = isc ? 256 : 2048; const int p0 = (isc ? r - 128 : r) * 16;
            __syncthreads();
            for (int i = tid; i < 16 * 33; i += NTHR) {
                const int pp = i / 33, e = i % 33; const int pos = p0 + pp;
                float v;
                if (e == 0) v = (float)pos / (float)(n - 1);
                else {
                    const int j = (e - 1) & 15; const float band = 1e-4f + (float)j * ((15.f - 1e-4f) / 15.f);
                    const float ang = 6.283185307179586f * (float)pos / (float)n;
                    v = (e <= 16) ? cosf(band * ang) : -sinf(band * ang);
                }
                zs[i] = v;
            }
            __syncthreads();
            for (int i = tid; i < 16 * 64; i += NTHR) {
                const int pp = i >> 6, uu = i & 63; float s = a.in[I_HB1][l * 64 + uu];
                for (int e = 0; e < 33; ++e) s += zs[pp * 33 + e] * a.in[I_HW1][(l * 33 + e) * 64 + uu];
                h1[i] = sinf(a.in[I_HF1][l * 64 + uu] * s);
            }
            __syncthreads();
            for (int i = tid; i < 16 * 64; i += NTHR) {
                const int pp = i >> 6, uu = i & 63; float s = a.in[I_HB2][l * 64 + uu];
                for (int e = 0; e < 64; ++e) s += h1[pp * 64 + e] * a.in[I_HW2][(l * 64 + e) * 64 + uu];
                h2[i] = sinf(a.in[I_HF2][l * 64 + uu] * s);
            }
            __syncthreads();
            bf16_t* G = isc ? (bf16_t*)(ws + WS_GFC) + (size_t)l * 2 * 512 * 512 : (bf16_t*)(ws + WS_GF) + (size_t)l * 2 * 512 * 4096;
            for (int q = 0; q < 4; ++q) {
                const int col = tid + NTHR * q;
                const int f = col >> 9, c = col & 511, o = f >> 1, bwd = f & 1;
                float acc[16];
#pragma unroll
                for (int pp = 0; pp < 16; ++pp) acc[pp] = 0.f;
                const float* w3 = a.in[I_HW3] + (size_t)l * 64 * 2048 + col;
                for (int e = 0; e < 64; ++e) {
                    const float w = w3[(size_t)e * 2048];
#pragma unroll
                    for (int pp = 0; pp < 16; ++pp) acc[pp] += h2[pp * 64 + e] * w;
                }
                const float lo = -3.0701134573253944f, hi = -15.350567286626972f;
                const float delta = fabsf(lo + (float)c * ((hi - lo) / 511.f));
                bf16_t* Gr = G + ((size_t)o * 512 + c) * (2 * n);
#pragma unroll
                for (int pp = 0; pp < 16; ++pp) {
                    const int pos = p0 + pp; const float t = (float)pos / (float)(n - 1);
                    float v = acc[pp] * expf(-t * delta);
                    if (!bwd) { if (pos == 0) v += a.in[I_HSKIP][(l * 2 + o) * 512 + c]; Gr[n - pos] = (bf16_t)f2bf(v); }
                    else if (pos > 0) Gr[n + pos] = (bf16_t)f2bf(v);
                    else Gr[0] = 0;
                }
            }
        }
        __syncthreads();
    }
}

__device__ __forceinline__ void norm_phase(const Ctx& a, const int wvs, int l) {
    const int tid = ltid(), lane = tid & 63, wave = tid >> 6;
    const int gw = blockIdx.x * 8 + wave, NGW = gridDim.x * 8;
    const float* xl = (l == 0) ? a.in[I_X] : a.out;
    const float* xc = (l == 0) ? a.in[I_CTX] : (const float*)(a.ws + WS_XC);
    const float* mod = (const float*)(a.ws + WS_MOD) + (size_t)l * 17 * 6144;
    const float* g = a.in[I_NORMG] + l * DM;
    bf16_t* H = (bf16_t*)(a.ws + WS_H);
    for (int row = gw; row < TOK; row += NGW) {
        const bool lat = row < TOKL;
        const float* xr = lat ? xl + (size_t)row * DM : xc + (size_t)(row - TOKL) * DM;
        const float* mr = mod + (lat ? (row >> 11) : 16) * 6144;
        f32x4 v[8]; float ss = 0.f;
#pragma unroll
        for (int j = 0; j < 8; ++j) { v[j] = *((const f32x4*)xr + lane + 64 * j); ss += (v[j].x * v[j].x + v[j].y * v[j].y) + (v[j].z * v[j].z + v[j].w * v[j].w); }
        const float rstd = 1.f / sqrtf(wave_sum(ss) * (1.f / DM) + 1e-6f);
#pragma unroll
        for (int j = 0; j < 8; ++j) {
            const int c = 4 * (lane + 64 * j);
            const f32x4 gg = *(const f32x4*)(g + c), sh = *(const f32x4*)(mr + c), sc = *(const f32x4*)(mr + 2048 + c);
            const f32x4 y = (v[j] * rstd) * gg * (sc + 1.f) + sh;
            u32x2 o; o.x = pk2(y.x, y.y); o.y = pk2(y.z, y.w);
            *(u32x2*)(H + (size_t)row * DM + c) = o;
        }
    }
}
#ifndef REP_HY_MM
#define REP_HY_MM 1
#endif
#ifndef REP_RW_CHAIN
#define REP_RW_CHAIN 1
#endif
#ifndef REP_RW_FEAT
#define REP_RW_FEAT 1
#endif
#ifndef REP_SYNC
#define REP_SYNC 1
#endif
#define GSYNC() do { for (int rs_ = 0; rs_ < REP_SYNC; ++rs_) xcd_barrier(xbar, wvs); } while (0)
#ifndef REP_ATT_STAGE
#define REP_ATT_STAGE 1
#endif
#ifndef REP_ATT_S
#define REP_ATT_S 1
#endif
#ifndef REP_RWKV
#define REP_RWKV 1
#endif
#ifndef REP_S5
#define REP_S5 1
#endif
#ifndef REP_ATT
#define REP_ATT 1
#endif
#ifndef REP_HY
#define REP_HY 1
#endif
#ifndef REP_CONV
#define REP_CONV 1
#endif
#ifndef REP_NORM
#define REP_NORM 1
#endif
#ifndef REP_MERGE
#define REP_MERGE 1
#endif
#ifndef REP_P0
#define REP_P0 1
#endif
#ifndef REP_INPROJ
#define REP_INPROJ 1
#endif
#ifndef REP_GLU
#define REP_GLU 1
#endif
#ifndef REP_HYPROJ
#define REP_HYPROJ 1
#endif
__device__ __forceinline__ float softplusf(float x) { return fmaxf(x, 0.f) + log1pf(expf(-fabsf(x))); }

typedef float f32x2 __attribute__((ext_vector_type(2)));
__device__ __forceinline__ float fsig(float x) { return __builtin_amdgcn_rcpf(1.f + __expf(-x)); }
struct RwChunk { int len, cs, rowbase; };
__device__ __forceinline__ RwChunk rw_chunk(int cc, int b) { RwChunk r; const bool isc = cc < 8; r.len = isc ? CTXL : SEQ; r.cs = isc ? cc : cc - 8; r.rowbase = isc ? TOKL + b * CTXL : b * SEQ; return r; }

__device__ __forceinline__ void rwkv_chain(const Ctx& a, const int wvs, unsigned char* lds, int l, int b, int hd, int di) {
    const int tid = ltid(), lane = tid & 63, wave = __builtin_amdgcn_readfirstlane(tid >> 6);
    float* IN = (float*)lds;
    float* YS = (float*)(lds + 98304);
    const bf16_t* proj = (const bf16_t*)(a.ws + WS_PROJ);
    __syncthreads();
    if (wave < 4) {
        f32x2 S0[4], S1[4];
#pragma unroll
        for (int j = 0; j < 4; ++j) { S0[j] = (f32x2){0.f, 0.f}; S1[j] = (f32x2){0.f, 0.f}; }
        const int i2 = tid >> 3, so = tid & 7;
#pragma unroll 1
        for (int k = 0; k < 74; ++k) {
            if (k >= 1 && k <= 72) {
                const float* INb = IN + ((k - 1) & 1) * 12288; float* YSb = YS + ((k - 1) & 1) * 2048;
#define RW_LD(tt_, P) do { const float* q_ = INb + (tt_) * 384 + 8 * so; P##ka = *(const f32x4*)(q_ + 256); P##kb = *(const f32x4*)(q_ + 260); P##wa = *(const f32x4*)(q_ + 64); P##wb = *(const f32x4*)(q_ + 68); \
                    P##ba = *(const f32x4*)(q_ + 320); P##bb = *(const f32x4*)(q_ + 324); P##da = *(const f32x4*)(q_ + 128); P##db = *(const f32x4*)(q_ + 132); P##ra = *(const f32x4*)(q_); P##rb = *(const f32x4*)(q_ + 4); \
                    P##v2 = *(const f32x2*)(INb + (tt_) * 384 + 192 + 2 * i2); } while (0)
#define RW_STEP(tt_, P) do { \
                    f32x2 t0 = S0[0] * P##ka.xy, t1 = S1[0] * P##ka.xy; \
                    t0 += S0[1] * P##ka.zw; t1 += S1[1] * P##ka.zw; t0 += S0[2] * P##kb.xy; t1 += S1[2] * P##kb.xy; t0 += S0[3] * P##kb.zw; t1 += S1[3] * P##kb.zw; \
                    const float sa0 = -sum8(t0.x + t0.y), sa1 = -sum8(t1.x + t1.y); \
                    const f32x2 s0v = {sa0, sa0}, s1v = {sa1, sa1}, v0v = {P##v2.x, P##v2.x}, v1v = {P##v2.y, P##v2.y}; \
                    S0[0] = S0[0] * P##wa.xy + (s0v * P##ba.xy + v0v * P##da.xy); S1[0] = S1[0] * P##wa.xy + (s1v * P##ba.xy + v1v * P##da.xy); \
                    S0[1] = S0[1] * P##wa.zw + (s0v * P##ba.zw + v0v * P##da.zw); S1[1] = S1[1] * P##wa.zw + (s1v * P##ba.zw + v1v * P##da.zw); \
                    S0[2] = S0[2] * P##wb.xy + (s0v * P##bb.xy + v0v * P##db.xy); S1[2] = S1[2] * P##wb.xy + (s1v * P##bb.xy + v1v * P##db.xy); \
                    S0[3] = S0[3] * P##wb.zw + (s0v * P##bb.zw + v0v * P##db.zw); S1[3] = S1[3] * P##wb.zw + (s1v * P##bb.zw + v1v * P##db.zw); \
                    f32x2 y0 = S0[0] * P##ra.xy, y1 = S1[0] * P##ra.xy; \
                    y0 += S0[1] * P##ra.zw; y1 += S1[1] * P##ra.zw; y0 += S0[2] * P##rb.xy; y1 += S1[2] * P##rb.xy; y0 += S0[3] * P##rb.zw; y1 += S1[3] * P##rb.zw; \
                    const float ys0 = sum8(y0.x + y0.y), ys1 = sum8(y1.x + y1.y); \
                    *(f32x2*)(YSb + (tt_) * 64 + 2 * i2) = (f32x2){ys0, ys1}; } while (0)
                f32x4 Aka, Akb, Awa, Awb, Aba, Abb, Ada, Adb, Ara, Arb; f32x2 Av2;
                f32x4 Bka, Bkb, Bwa, Bwb, Bba, Bbb, Bda, Bdb, Bra, Brb; f32x2 Bv2;
                f32x2 Sv0[4], Sv1[4];
#pragma unroll
                for (int j = 0; j < 4; ++j) { Sv0[j] = S0[j]; Sv1[j] = S1[j]; }
                for (int rep_ = 0; rep_ < REP_RW_CHAIN; ++rep_) {
#pragma unroll
                for (int j = 0; j < 4; ++j) { S0[j] = Sv0[j]; S1[j] = Sv1[j]; }
                RW_LD(0, A);
#pragma unroll 1
                for (int tt = 0; tt < 32; tt += 2) {
                    RW_LD(tt + 1, B);
                    RW_STEP(tt, A);
                    RW_LD((tt + 2) & 31, A);
                    RW_STEP(tt + 1, B);
                }
                }
#undef RW_LD
#undef RW_STEP
            }
            BAR_LDS();
        }
    } else {
        const int fw = wave - 4, ch = hd * 64 + lane;
        float* LWA = (float*)(lds + 114688) + fw * 512;
        bf16_t* yrw = (bf16_t*)(a.ws + WS_YRW) + (size_t)di * TOK * 512;
        float* bonus = (float*)(a.ws + WS_BONUS) + (size_t)di * TOK * 8;
        bf16_t* vmix = (bf16_t*)(a.ws + WS_VMIX);
        const float* mup = a.in[I_MUP] + l * 1664; const float* mun = a.in[I_MUN] + l * 1664;
        f32x2 w2p[16], a2p[16];
#pragma unroll
        for (int m = 0; m < 16; ++m) {
            w2p[m] = (f32x2){a.in[I_W2][(((size_t)l * 2 + di) * 32 + 2 * m) * 512 + ch], a.in[I_W2][(((size_t)l * 2 + di) * 32 + 2 * m + 1) * 512 + ch]};
            a2p[m] = (f32x2){a.in[I_A2][(((size_t)l * 2 + di) * 32 + 2 * m) * 512 + ch], a.in[I_A2][(((size_t)l * 2 + di) * 32 + 2 * m + 1) * 512 + ch]};
        }
        const float f_w0 = a.in[I_W0][(l * 2 + di) * 512 + ch], f_a0 = a.in[I_A0][(l * 2 + di) * 512 + ch];
        const float f_kk = a.in[I_KK][l * 512 + ch], f_ka = a.in[I_KA][l * 512 + ch], f_rk = a.in[I_RK][l * 512 + ch];
        const float mp_r = mup[ch], mn_r = mun[ch], mp_k = mup[512 + ch], mn_k = mun[512 + ch], mp_v = mup[1024 + ch], mn_v = mun[1024 + ch];
        const int lc = (lane < 32) ? (di * 32 + lane) : ((2 + di) * 32 + (lane - 32));
        const float mp_l = mup[1536 + lc], mn_l = mun[1536 + lc];
        unsigned short rr[10], rk[10], rv[10], rl[10];
#define RW_LOAD(cc) do { const RwChunk c_ = rw_chunk((cc), b); const int nsc0_ = c_.cs * 32 + 8 * fw; const int plo_ = di ? (c_.len - 1 - nsc0_ - 7) : nsc0_; \
        _Pragma("unroll") for (int j = 0; j < 10; ++j) { const int p_ = plo_ - 1 + j; const bool ok_ = (p_ >= 0) && (p_ < c_.len); \
            const GAS1 bf16_t* pr_ = (const GAS1 bf16_t*)proj + (size_t)(c_.rowbase + (ok_ ? p_ : 0)) * NMAIN; \
            rr[j] = ok_ ? pr_[C_RKV + ch] : (bf16_t)0; rk[j] = ok_ ? pr_[C_RKV + 512 + ch] : (bf16_t)0; rv[j] = ok_ ? pr_[C_RKV + 1024 + ch] : (bf16_t)0; rl[j] = ok_ ? pr_[C_LORA + lc] : (bf16_t)0; } } while (0)
        RW_LOAD(0);
#pragma unroll 1
        for (int k = 0; k < 74; ++k) {
            if (k >= 2) {
                const RwChunk c = rw_chunk(k - 2, b); const float* YSb = YS + ((k - 2) & 1) * 2048;
#pragma unroll
                for (int j = 0; j < 8; ++j) {
                    const int tt = 8 * fw + j, nsc = c.cs * 32 + tt, p = di ? (c.len - 1 - nsc) : nsc;
                    ((GAS1 bf16_t*)yrw)[(size_t)(c.rowbase + p) * 512 + ch] = (bf16_t)f2bf(YSb[tt * 64 + lane]);
                }
            }
            if (k <= 71) {
                const RwChunk c = rw_chunk(k, b); const int nsc0 = c.cs * 32 + 8 * fw; const int plo = di ? (c.len - 1 - nsc0 - 7) : nsc0;
                float zr[8], zk[8], zv[8];
#pragma unroll
                for (int j = 0; j < 8; ++j) {
                    const float r0 = bf2f(rr[j + 1]), k0 = bf2f(rk[j + 1]), v0 = bf2f(rv[j + 1]), l0 = bf2f(rl[j + 1]);
                    zr[j] = r0 + mp_r * (bf2f(rr[j]) - r0) + mn_r * (bf2f(rr[j + 2]) - r0);
                    zk[j] = k0 + mp_k * (bf2f(rk[j]) - k0) + mn_k * (bf2f(rk[j + 2]) - k0);
                    zv[j] = v0 + mp_v * (bf2f(rv[j]) - v0) + mn_v * (bf2f(rv[j + 2]) - v0);
                    const float zl = l0 + mp_l * (bf2f(rl[j]) - l0) + mn_l * (bf2f(rl[j + 2]) - l0);
                    const float th = 1.f - 2.f * __builtin_amdgcn_rcpf(1.f + __expf(2.f * zl));
                    LWA[j * 64 + lane] = (lane < 32) ? th : zl;
                }
                if (k + 1 <= 71) RW_LOAD(k + 1);
                LDS_WAIT();
                float* INb = IN + (k & 1) * 12288;
                for (int rep_ = 0; rep_ < REP_RW_FEAT; ++rep_)
#pragma unroll
                for (int j = 0; j < 8; ++j) {
                    const int tt = di ? (8 * fw + 7 - j) : (8 * fw + j);
                    const int row = c.rowbase + plo + j;
                    const float kkp = zk[j] * f_kk;
                    const float kk = kkp * __builtin_amdgcn_rsqf(wave_sum(kkp * kkp) + 1e-12f);
                    f32x4 lw[8], la[8];
#pragma unroll
                    for (int m4 = 0; m4 < 8; ++m4) { lw[m4] = *(const f32x4*)(LWA + j * 64 + 4 * m4); la[m4] = *(const f32x4*)(LWA + j * 64 + 32 + 4 * m4); }
                    f32x2 wa2 = {f_w0, 0.f}, aa2 = {f_a0, 0.f};
#pragma unroll
                    for (int m4 = 0; m4 < 8; ++m4) {
                        wa2 += lw[m4].xy * w2p[2 * m4]; wa2 += lw[m4].zw * w2p[2 * m4 + 1];
                        aa2 += la[m4].xy * a2p[2 * m4]; aa2 += la[m4].zw * a2p[2 * m4 + 1];
                    }
                    const float wacc = wa2.x + wa2.y, aacc = aa2.x + aa2.y;
                    const float decay = __expf(-0.6065306597126334f * fsig(wacc));
                    const float av = fsig(aacc);
                    const float kd = zk[j] * (1.f + (av - 1.f) * f_ka);
                    const float bsum = wave_sum(zr[j] * kd * f_rk);
                    if (lane == 0) ((GAS1 float*)bonus)[(size_t)row * 8 + hd] = bsum;
                    float* o = INb + tt * 384 + lane;
                    o[0] = zr[j]; o[64] = decay; o[128] = kd; o[192] = zv[j]; o[256] = kk; o[320] = kk * av;
                    if (di == 0) ((GAS1 bf16_t*)vmix)[(size_t)row * 512 + ch] = (bf16_t)f2bf(zv[j]);
                }
            }
            BAR_LDS();
        }
#undef RW_LOAD
    }
    __syncthreads();
}

__device__ __forceinline__ void unpack8(const u32x4 w, float (&v)[8]) {
    v[0] = bflo(w.x); v[1] = bfhi(w.x); v[2] = bflo(w.y); v[3] = bfhi(w.y); v[4] = bflo(w.z); v[5] = bfhi(w.z); v[6] = bflo(w.w); v[7] = bfhi(w.w);
}
__device__ __forceinline__ u32x4 pack8(const float (&v)[8]) { return (u32x4){pk2(v[0], v[1]), pk2(v[2], v[3]), pk2(v[4], v[5]), pk2(v[6], v[7])}; }
__device__ __forceinline__ float gelu_erf(float v) {
    const float av = fabsf(v), t = __builtin_amdgcn_rcpf(av * 0.2316418882f + 1.0f);
    float q = t * 0.5307027145f + (-0.7265760135f); q = q * t + 0.7107068705f; q = q * t + (-0.142248368f); q = q * t + 0.127414796f; q = q * t;
    const float e = __builtin_amdgcn_exp2f((v * v) * (-0.72134752044f));
    const float m = v * (q * e), r = v - m;
    return v < 0.f ? m : r;
}

__device__ __forceinline__ unsigned cvt_pk_bf16f(float lo, float hi) { unsigned r; asm volatile("v_cvt_pk_bf16_f32 %0, %1, %2" : "=v"(r) : "v"(lo), "v"(hi)); return r; }

__device__ __forceinline__ void s5_chain(const Ctx& a, const int wvs, unsigned char* ldsw, int l, int b, int g, int di) {
    const int lane = ltid() & 63;
    float* BU = (float*)ldsw;
    bf16_t* HB = (bf16_t*)(ldsw + 16384);
    const bf16_t* proj = (const bf16_t*)(a.ws + WS_PROJ);
    bf16_t* ys = (bf16_t*)(a.ws + (di ? WS_YSB : WS_YSF));
    const int p1 = lane & 31, hi = lane >> 5, n16 = lane & 15, q4 = lane >> 4;
    const int pg = ((l * 2 + di) * 32 + g);
    const float* lbt = (const float*)(a.ws + WS_S5LB); const float* bbt = (const float*)(a.ws + WS_S5BB);
    bf16x8 Bf[4];
#pragma unroll
    for (int nt = 0; nt < 4; ++nt) {
        const int pp = nt * 16 + (p1 >> 1), im = p1 & 1;
        const float* bp = bbt + (((size_t)pg * 64 + pp) * 16 + 8 * hi) * 2 + im;
        bf16x8 f;
#pragma unroll
        for (int jj = 0; jj < 8; ++jj) f[jj] = (short)f2bf(bp[2 * jj]);
        Bf[nt] = f;
    }
    const float ar = lbt[((size_t)pg * 64 + lane) * 2], ai = lbt[((size_t)pg * 64 + lane) * 2 + 1];
    bf16x8 Cf[4];
#pragma unroll
    for (int ks = 0; ks < 4; ++ks) {
        const int k0 = ks * 32 + 8 * q4;
        const float* cr = a.in[I_CRE] + ((size_t)pg * 16 + n16) * 64 + (k0 >> 1);
        const float* ci = a.in[I_CIM] + ((size_t)pg * 16 + n16) * 64 + (k0 >> 1);
        bf16x8 f;
#pragma unroll
        for (int jj = 0; jj < 4; ++jj) { f[2 * jj] = (short)f2bf(cr[jj]); f[2 * jj + 1] = (short)f2bf(-ci[jj]); }
        Cf[ks] = f;
    }
    float hr = 0.f, him = 0.f;
#define S5_LOADA(ci_, dst) do { const bool isc_ = (ci_) < 8; const int len_ = isc_ ? CTXL : SEQ; const int cs_ = isc_ ? (ci_) : (ci_) - 8; const int rb_ = isc_ ? TOKL + b * CTXL : b * SEQ; \
        const int nsc_ = cs_ * 32 + p1; const int p_ = di ? (len_ - 1 - nsc_) : nsc_; dst = *(const GAS1 bf16x8*)((const GAS1 bf16_t*)proj + (size_t)(rb_ + p_) * NMAIN + C_S5 + g * 16 + 8 * hi); } while (0)
    bf16x8 Anext; S5_LOADA(0, Anext);
#pragma unroll 1
    for (int ci = 0; ci < 72; ++ci) {
        const bool isc = ci < 8; const int len = isc ? CTXL : SEQ; const int cs = isc ? ci : ci - 8;
        const int rowbase = isc ? TOKL + b * CTXL : b * SEQ;
        const bf16x8 A = Anext;
        if (ci + 1 < 72) S5_LOADA(ci + 1, Anext);
#pragma unroll
        for (int nt = 0; nt < 4; ++nt) {
            f32x16 acc;
#pragma unroll
            for (int r = 0; r < 16; ++r) acc[r] = 0.f;
            acc = __builtin_amdgcn_mfma_f32_32x32x16_bf16(A, Bf[nt], acc, 0, 0, 0);
#pragma unroll
            for (int r = 0; r < 16; ++r) BU[(8 * (r >> 2) + 4 * hi + (r & 3)) * 128 + nt * 32 + p1] = acc[r];
        }
        LDS_WAIT();
#pragma unroll 1
        for (int t0 = 0; t0 < 32; t0 += 8) {
            f32x2 bu[8];
#pragma unroll
            for (int k = 0; k < 8; ++k) bu[k] = *(const f32x2*)(BU + (t0 + k) * 128 + 2 * lane);
#pragma unroll
            for (int k = 0; k < 8; ++k) {
                const float nr = ar * hr - ai * him + bu[k].x, ni = ar * him + ai * hr + bu[k].y;
                hr = nr; him = ni;
                *(unsigned*)(HB + (t0 + k) * 136 + 2 * lane) = cvt_pk_bf16f(hr, him);
            }
        }
        LDS_WAIT();
#pragma unroll
        for (int mt = 0; mt < 2; ++mt) {
            f32x4 y = {0.f, 0.f, 0.f, 0.f};
#pragma unroll
            for (int ks = 0; ks < 4; ++ks) {
                const bf16x8 Ah = *(const bf16x8*)(HB + (mt * 16 + n16) * 136 + ks * 32 + 8 * q4);
                y = __builtin_amdgcn_mfma_f32_16x16x32_bf16(Ah, Cf[ks], y, 0, 0, 0);
            }
#pragma unroll
            for (int j = 0; j < 4; ++j) {
                const int nsc = cs * 32 + mt * 16 + 4 * q4 + j; const int p = di ? (len - 1 - nsc) : nsc;
                ((GAS1 bf16_t*)ys)[(size_t)(rowbase + p) * 512 + g * 16 + n16] = (bf16_t)f2bf(y[j]);
            }
        }
        LDS_WAIT();
    }
#undef S5_LOADA
}

__device__ __forceinline__ void s5_combine(const Ctx& a, const int wvs, int l, int pr0) {
    const int tid = ltid();
    const bf16_t* proj = (const bf16_t*)(a.ws + WS_PROJ);
    const bf16_t* yf = (const bf16_t*)(a.ws + WS_YSF); const bf16_t* yb = (const bf16_t*)(a.ws + WS_YSB);
    bf16_t* ygelu = (bf16_t*)(a.ws + WS_YGELU);
#pragma unroll 3
    for (int i = tid; i < 2304 * 4; i += NTHR) {
        const int half = i & 1, pr = pr0 + ((i >> 1) & 1), tok = i >> 2;
        const int b = pr >> 5, g = pr & 31;
        const int row = tok < CTXL ? TOKL + b * CTXL + tok : b * SEQ + (tok - CTXL);
        const size_t idx = (size_t)row * 512 + g * 16 + 8 * half;
        const u32x4 fw = *(const u32x4*)(yf + idx), bw = *(const u32x4*)(yb + idx);
        const u32x4 uw = *(const u32x4*)(proj + (size_t)row * NMAIN + C_S5 + g * 16 + 8 * half);
        const float* dk = a.in[I_S5D] + (l * 32 + g) * 16 + 8 * half;
        float v[8], vb[8]; unpack8(fw, v); unpack8(bw, vb);
#pragma unroll
        for (int e = 0; e < 8; ++e) v[e] += vb[e];
        float u[8]; unpack8(uw, u);
#pragma unroll
        for (int e = 0; e < 8; ++e) v[e] = gelu_erf(v[e] + dk[e] * u[e]);
        *(u32x4*)(ygelu + idx) = pack8(v);
    }
}

__device__ __forceinline__ void attn_unit(const Ctx& a, const int wvs, unsigned char* lds, int l, int b, int hp, int qb, bool qctx) {
    const int tid = ltid(), lane = tid & 63, wave = tid >> 6, n16 = lane & 15, q4 = lane >> 4;
    bf16_t* Ks = (bf16_t*)lds;
    bf16_t* Vt = (bf16_t*)(lds + 18432);
    const bf16_t* proj = (const bf16_t*)(a.ws + WS_PROJ);
    bf16_t* yatt = (bf16_t*)(a.ws + WS_YATT);
    const float* qg = a.in[I_QG] + l * 64; const float* kg = a.in[I_KG] + l * 64;
    const float* rope = (const float*)(a.ws + WS_ROPE);
    const int kvh = hp >> 1;
    const float LOG2E = 1.4426950408889634f;
    const int qi = wave * 16 + n16;
    const int qpos = qb * 128 + qi;
    const int qrow = qctx ? TOKL + b * CTXL + qpos : b * SEQ + qpos;
#define ATT_VALID(t) (((t) >= 3) || (!qctx && (qb - 1 + (t)) >= 0 && (qb - 1 + (t)) <= 15))
#define ATT_KROW0(t) (((t) < 3) ? b * SEQ + (qb - 1 + (t)) * 128 : TOKL + b * CTXL + ((t) - 3) * 128)
    u32x2 kra[2], krb[2]; u32x4 vr[2];
#define ATT_LOAD(t) do { const int kr0_ = ATT_KROW0(t); _Pragma("unroll") for (int i = 0; i < 2; ++i) { const int tk = tid + NTHR * i; const int key = tk >> 3, sub = tk & 7, hf = sub >> 2, aa = sub & 3; \
        const GAS1 bf16_t* kp = (const GAS1 bf16_t*)proj + (size_t)(kr0_ + key) * NMAIN + C_K + kvh * 64 + hf * 32 + 4 * aa; kra[i] = *(const GAS1 u32x2*)kp; krb[i] = *(const GAS1 u32x2*)(kp + 16); \
        vr[i] = *(const GAS1 u32x4*)((const GAS1 bf16_t*)proj + (size_t)(kr0_ + key) * NMAIN + C_V + kvh * 64 + 8 * sub); } } while (0)
    int t = 0;
    while (!ATT_VALID(t)) ++t;
    ATT_LOAD(t);
    bf16x8 Qf[2][2];
    float m[2], lsum[2];
    f32x4 o[2][4];
#pragma unroll
    for (int h2 = 0; h2 < 2; ++h2) {
        const int hq = 2 * hp + h2;
        float va[2][4], vb[2][4]; float ss = 0.f;
#pragma unroll
        for (int hf = 0; hf < 2; ++hf) {
            const bf16_t* qp = proj + (size_t)qrow * NMAIN + C_Q + hq * 64 + hf * 32 + 4 * q4;
            const u32x2 wa = *(const u32x2*)qp, wb = *(const u32x2*)(qp + 16);
            va[hf][0] = bflo(wa.x); va[hf][1] = bfhi(wa.x); va[hf][2] = bflo(wa.y); va[hf][3] = bfhi(wa.y);
            vb[hf][0] = bflo(wb.x); vb[hf][1] = bfhi(wb.x); vb[hf][2] = bflo(wb.y); vb[hf][3] = bfhi(wb.y);
#pragma unroll
            for (int jj = 0; jj < 4; ++jj) ss += va[hf][jj] * va[hf][jj] + vb[hf][jj] * vb[hf][jj];
        }
        ss += __shfl_xor(ss, 16); ss += __shfl_xor(ss, 32);
        const float rstd = __builtin_amdgcn_rsqf(ss * (1.f / 64.f) + 1e-6f);
        const float qs = 0.125f * LOG2E;
#pragma unroll
        for (int hf = 0; hf < 2; ++hf) {
            const int ipos = (hf == 0 ? (qpos >> 6) : (qpos & 63));
            bf16x8 f;
#pragma unroll
            for (int jj = 0; jj < 4; ++jj) {
                const int i = 4 * q4 + jj;
                float u1 = va[hf][jj] * rstd * qg[hf * 32 + i], u2 = vb[hf][jj] * rstd * qg[hf * 32 + 16 + i];
                if (!qctx) {
                    const f32x2 csn = *(const GAS1 f32x2*)((const GAS1 float*)rope + (ipos * 16 + i) * 2);
                    const float o1 = u1 * csn.x - u2 * csn.y, o2 = u2 * csn.x + u1 * csn.y; u1 = o1; u2 = o2;
                }
                f[jj] = (short)f2bf(u1 * qs); f[4 + jj] = (short)f2bf(u2 * qs);
            }
            Qf[h2][hf] = f;
        }
        m[h2] = a.in[I_SINK][l * 8 + hq] * LOG2E; lsum[h2] = (q4 == 0) ? 1.f : 0.f;
#pragma unroll
        for (int i = 0; i < 4; ++i) o[h2][i] = (f32x4){0.f, 0.f, 0.f, 0.f};
    }
    const int vsw0 = ((n16 >> 3) & 1);
#pragma unroll 1
    while (t < 5) {
        int tn = t + 1;
        while (tn < 5 && !ATT_VALID(tn)) ++tn;
        const bool local = t < 3; const int kb = local ? qb - 1 + t : 0;
        BAR_LDS();
#pragma unroll
        for (int i = 0; i < 2; ++i) {
            const int tk = tid + NTHR * i; const int key = tk >> 3, sub = tk & 7, hf = sub >> 2, aa = sub & 3;
            const u32x2 wa = kra[i], wb = krb[i];
            float ua[4] = {bflo(wa.x), bfhi(wa.x), bflo(wa.y), bfhi(wa.y)}, ub[4] = {bflo(wb.x), bfhi(wb.x), bflo(wb.y), bfhi(wb.y)};
            float ss = 0.f;
#pragma unroll
            for (int jj = 0; jj < 4; ++jj) ss += ua[jj] * ua[jj] + ub[jj] * ub[jj];
            ss = sum8(ss);
            const float rstd = __builtin_amdgcn_rsqf(ss * (1.f / 64.f) + 1e-6f);
            const int kpos = kb * 128 + key;
            const int ipos = (hf == 0 ? (kpos >> 6) : (kpos & 63)) & 63;
            unsigned w[4];
            float oa[4], ob[4];
#pragma unroll
            for (int jj = 0; jj < 4; ++jj) {
                const int ii = 4 * aa + jj;
                float u1 = ua[jj] * rstd * ((const GAS1 float*)kg)[hf * 32 + ii], u2 = ub[jj] * rstd * ((const GAS1 float*)kg)[hf * 32 + 16 + ii];
                if (local) {
                    const f32x2 csn = *(const GAS1 f32x2*)((const GAS1 float*)rope + (ipos * 16 + ii) * 2);
                    const float o1 = u1 * csn.x - u2 * csn.y, o2 = u2 * csn.x + u1 * csn.y; u1 = o1; u2 = o2;
                }
                oa[jj] = u1; ob[jj] = u2;
            }
            w[0] = pk2(oa[0], oa[1]); w[1] = pk2(oa[2], oa[3]); w[2] = pk2(ob[0], ob[1]); w[3] = pk2(ob[2], ob[3]);
            *(u32x4*)(Ks + key * 72 + hf * 32 + 8 * aa) = (u32x4){w[0], w[1], w[2], w[3]};
            const u32x4 vv = vr[i];
            bf16_t* vt = Vt + (8 * sub) * 136 + (key ^ (sub << 3));
            vt[0] = (bf16_t)(vv.x & 0xffff); vt[136] = (bf16_t)(vv.x >> 16); vt[2 * 136] = (bf16_t)(vv.y & 0xffff); vt[3 * 136] = (bf16_t)(vv.y >> 16);
            vt[4 * 136] = (bf16_t)(vv.z & 0xffff); vt[5 * 136] = (bf16_t)(vv.z >> 16); vt[6 * 136] = (bf16_t)(vv.w & 0xffff); vt[7 * 136] = (bf16_t)(vv.w >> 16);
        }
        if (tn < 5) ATT_LOAD(tn);
        BAR_LDS();
        f32x4 s[2][8];
        const int dlo = (local && kb == qb - 1) ? wvs : 0;
        const int dhi = (local && kb == qb + 1) ? wvs : 7;
#pragma unroll
        for (int mt = 0; mt < 8; ++mt) {
            if (mt < dlo || mt > dhi) { s[0][mt] = (f32x4){-1e30f, -1e30f, -1e30f, -1e30f}; s[1][mt] = s[0][mt]; }
            else {
            s[0][mt] = (f32x4){0.f, 0.f, 0.f, 0.f}; s[1][mt] = (f32x4){0.f, 0.f, 0.f, 0.f};
#pragma unroll
            for (int hf = 0; hf < 2; ++hf) {
                const bf16x8 A = *(const bf16x8*)(Ks + (mt * 16 + n16) * 72 + hf * 32 + 8 * q4);
                s[0][mt] = __builtin_amdgcn_mfma_f32_16x16x32_bf16(A, Qf[0][hf], s[0][mt], 0, 0, 0);
                s[1][mt] = __builtin_amdgcn_mfma_f32_16x16x32_bf16(A, Qf[1][hf], s[1][mt], 0, 0, 0);
            }
            }
        }
        if (local && kb != qb) {
#pragma unroll
            for (int mt = 0; mt < 8; ++mt)
#pragma unroll
                for (int j = 0; j < 4; ++j) {
                    const int kpos = kb * 128 + mt * 16 + 4 * q4 + j; int df = qpos - kpos; df = df < 0 ? -df : df;
                    if (df > 128) { s[0][mt][j] = -1e30f; s[1][mt][j] = -1e30f; }
                }
        }
#pragma unroll
        for (int h2 = 0; h2 < 2; ++h2) {
            float mx = -3e38f;
#pragma unroll
            for (int mt = 0; mt < 8; ++mt) mx = fmaxf(fmaxf(fmaxf(s[h2][mt][0], s[h2][mt][1]), fmaxf(s[h2][mt][2], s[h2][mt][3])), mx);
            mx = fmaxf(mx, __shfl_xor(mx, 16)); mx = fmaxf(mx, __shfl_xor(mx, 32));
            const float mn = fmaxf(m[h2], mx), alpha = __builtin_amdgcn_exp2f(m[h2] - mn); m[h2] = mn;
            float ps = 0.f;
#pragma unroll
            for (int mt = 0; mt < 8; ++mt) {
                if (mt < dlo || mt > dhi) s[h2][mt] = (f32x4){0.f, 0.f, 0.f, 0.f};
                else {
#pragma unroll
                for (int j = 0; j < 4; ++j) { const float p = __builtin_amdgcn_exp2f(s[h2][mt][j] - mn); s[h2][mt][j] = p; ps += p; }
                }
            }
            lsum[h2] = lsum[h2] * alpha + ps;
#pragma unroll
            for (int i = 0; i < 4; ++i) o[h2][i] = o[h2][i] * alpha;
        }
#pragma unroll
        for (int ks = 0; ks < 4; ++ks) {
            if (2 * ks + 1 < dlo || 2 * ks > dhi) continue;
            bf16x8 Bp[2];
#pragma unroll
            for (int h2 = 0; h2 < 2; ++h2) {
                u32x4 bp;
                bp.x = cvt_pk_bf16f(s[h2][2 * ks][0], s[h2][2 * ks][1]); bp.y = cvt_pk_bf16f(s[h2][2 * ks][2], s[h2][2 * ks][3]);
                bp.z = cvt_pk_bf16f(s[h2][2 * ks + 1][0], s[h2][2 * ks + 1][1]); bp.w = cvt_pk_bf16f(s[h2][2 * ks + 1][2], s[h2][2 * ks + 1][3]);
                Bp[h2] = __builtin_bit_cast(bf16x8, bp);
            }
#pragma unroll
            for (int md = 0; md < 4; ++md) {
                const int sw = ((2 * md + vsw0) & 7) << 3;
                const bf16_t* vrow = Vt + (md * 16 + n16) * 136;
                const u32x2 v0 = *(const u32x2*)(vrow + ((ks * 32 + 4 * q4) ^ sw)), v1 = *(const u32x2*)(vrow + ((ks * 32 + 16 + 4 * q4) ^ sw));
                const bf16x8 av = __builtin_bit_cast(bf16x8, (u32x4){v0.x, v0.y, v1.x, v1.y});
                o[0][md] = __builtin_amdgcn_mfma_f32_16x16x32_bf16(av, Bp[0], o[0][md], 0, 0, 0);
                o[1][md] = __builtin_amdgcn_mfma_f32_16x16x32_bf16(av, Bp[1], o[1][md], 0, 0, 0);
            }
        }
        t = tn;
    }
#undef ATT_VALID
#undef ATT_KROW0
#undef ATT_LOAD
#pragma unroll
    for (int h2 = 0; h2 < 2; ++h2) {
        float ls = lsum[h2];
        ls += __shfl_xor(ls, 16); ls += __shfl_xor(ls, 32);
        const float il = __builtin_amdgcn_rcpf(ls);
#pragma unroll
        for (int md = 0; md < 4; ++md) {
            u32x2 w; w.x = pk2(o[h2][md][0] * il, o[h2][md][1] * il); w.y = pk2(o[h2][md][2] * il, o[h2][md][3] * il);
            *(u32x2*)(yatt + (size_t)qrow * 512 + (2 * hp + h2) * 64 + md * 16 + 4 * q4) = w;
        }
    }
}

__device__ __forceinline__ unsigned fsr16(unsigned lo, unsigned hi) { return __builtin_amdgcn_alignbit(hi, lo, 16); }

__device__ __forceinline__ void hyena_item(const Ctx& a, const int wvs, unsigned char* lds, int l, int c, bool isc) {
    const int tid = ltid(), lane = tid & 63, wave = tid >> 6, n16 = lane & 15, q4 = lane >> 4;
    const int n = isc ? CTXL : SEQ, tokbase = isc ? TOKL : 0, UST = n + 8, GST = 2 * n + 16;
    bf16_t* Ub = (bf16_t*)lds;
    bf16_t* Gs = (bf16_t*)(lds + 16 * UST * 2);
    const bf16_t* hyT = (const bf16_t*)(a.ws + WS_HYT);
    bf16_t* yh = (bf16_t*)(a.ws + WS_YHYT);
    const float* cw = a.in[I_HCW] + (size_t)l * 3 * 1536; const float* cb = a.in[I_HCB] + (size_t)l * 1536;
    u32x2 yst0[8], yst1[8];
#pragma unroll
    for (int r = 0; r < 8; ++r) { yst0[r] = (u32x2){0u, 0u}; yst1[r] = (u32x2){0u, 0u}; }
#pragma unroll 1
    for (int o = 0; o < 2; ++o) {
        BAR_LDS();
        const int n8 = n >> 3;
        u32x4 g0pre;
        {
            const bf16_t* Gp = isc ? (const bf16_t*)(a.ws + WS_GFC) + (((size_t)l * 2 + o) * 512 + c) * 512 : (const bf16_t*)(a.ws + WS_GF) + (((size_t)l * 2 + o) * 512 + c) * 4096;
            g0pre = (tid < 2 * n8) ? *(const u32x4*)(Gp + 8 * tid) : (u32x4){0u, 0u, 0u, 0u};
        }
        if (o == 0) {
            const bf16_t* src = hyT + (size_t)c * TOK + tokbase;
            const float w0 = cw[c], w1 = cw[1536 + c], w2 = cw[3072 + c], bs = cb[c];
#pragma unroll 8
            for (int i = tid; i < 16 * n8; i += NTHR) {
                const int bb = i / n8, t8 = (i - bb * n8) * 8;
                const bf16_t* s = src + bb * n + t8;
                float v[10]; float e[8];
                unpack8(*(const u32x4*)s, e);
                v[0] = t8 > 0 ? bf2f(s[-1]) : 0.f; v[9] = (t8 + 8 < n) ? bf2f(s[8]) : 0.f;
#pragma unroll
                for (int k = 0; k < 8; ++k) v[k + 1] = e[k];
                float r[8];
#pragma unroll
                for (int k = 0; k < 8; ++k) r[k] = w0 * v[k] + w1 * v[k + 1] + w2 * v[k + 2] + bs;
                *(u32x4*)(Ub + bb * UST + t8) = pack8(r);
            }
        } else {
#pragma unroll 1
            for (int gi = 0; gi < 2; ++gi) {
                const int grp = wave + 8 * gi;
                if (grp < (n >> 7)) {
#pragma unroll
                    for (int r = 0; r < 8; ++r) *(u32x2*)(Ub + n16 * UST + 16 * (grp * 8 + r) + 4 * q4) = (gi == 0) ? yst0[r] : yst1[r];
                }
            }
        }
        {
            const bf16_t* G = isc ? (const bf16_t*)(a.ws + WS_GFC) + (((size_t)l * 2 + o) * 512 + c) * 512 : (const bf16_t*)(a.ws + WS_GF) + (((size_t)l * 2 + o) * 512 + c) * 4096;
            const int nch = GST >> 3;
            *(u32x4*)(Gs + 8 * tid) = g0pre;
            for (int m = tid + NTHR; m < nch; m += NTHR) *(u32x4*)(Gs + 8 * m) = (m < 2 * n8) ? *(const u32x4*)(G + 8 * m) : (u32x4){0u, 0u, 0u, 0u};
            BAR_LDS();
            for (int m = tid; m < nch; m += NTHR) {
                const u32x4 hi4 = *(const u32x4*)(Gs + 8 * m);
                const u32x4 lo4 = (m > 0) ? *(const u32x4*)(Gs + 8 * m - 8) : (u32x4){0u, 0u, 0u, 0u};
                const unsigned d[8] = {lo4.x, lo4.y, lo4.z, lo4.w, hi4.x, hi4.y, hi4.z, hi4.w};
#pragma unroll
                for (int k = 1; k < 8; ++k) {
                    u32x4 w;
                    if ((k & 1) == 0) { w.x = d[4 - k / 2]; w.y = d[5 - k / 2]; w.z = d[6 - k / 2]; w.w = d[7 - k / 2]; }
                    else { const int s = (8 - k) >> 1; w.x = fsr16(d[s], d[s + 1]); w.y = fsr16(d[s + 1], d[s + 2]); w.z = fsr16(d[s + 2], d[s + 3]); w.w = (s + 4 < 8) ? fsr16(d[s + 3], d[s + 4]) : 0u; }
                    *(u32x4*)(Gs + k * GST + 8 * m) = w;
                }
            }
        }
        BAR_LDS();
        const int xch = 512 * (o + 1) + c;
        const float xw0 = cw[xch], xw1 = cw[1536 + xch], xw2 = cw[3072 + xch], xbs = cb[xch];
        const bf16_t* xsrc = hyT + (size_t)xch * TOK + tokbase + n16 * n;
        bf16_t* dst = yh + (size_t)c * TOK + tokbase + n16 * n;
        const bf16_t* gl = Gs + (n16 & 7) * GST + n + 8 * q4 - 8 * (n16 >> 3);
        const bf16_t* bbp = Ub + n16 * UST + 8 * q4;
#pragma unroll 1
        for (int gi = 0; gi < 2; ++gi) {
            const int grp = wave + 8 * gi;
            if (grp < (n >> 7)) {
            const int tau0 = grp * 8;
            bf16x8 Af[8]; f32x4 acc[8];
#pragma unroll
            for (int r = 0; r < 8; ++r) acc[r] = (f32x4){0.f, 0.f, 0.f, 0.f};
#pragma unroll
            for (int r = 2; r < 8; ++r) Af[r] = *(const bf16x8*)(gl - 16 * (tau0 + r));
            u32x2 xm[8]; bf16_t xl[8], xr[8];
#pragma unroll
            for (int r = 0; r < 8; ++r) {
                const int tb = 16 * (tau0 + r) + 4 * q4;
                xm[r] = *(const GAS1 u32x2*)((const GAS1 bf16_t*)xsrc + tb);
                xl[r] = (tb > 0) ? ((const GAS1 bf16_t*)xsrc)[tb - 1] : (bf16_t)0;
                xr[r] = (tb + 4 < n) ? ((const GAS1 bf16_t*)xsrc)[tb + 4] : (bf16_t)0;
            }
#pragma unroll 1
            for (int s4 = 0; s4 < (n >> 5); s4 += 4) {
#pragma unroll
                for (int u = 0; u < 4; ++u) {
                    const int sg = s4 + u;
                    Af[(8 - 2 * u) & 7] = *(const bf16x8*)(gl - 16 * (tau0 - 2 * sg));
                    Af[(9 - 2 * u) & 7] = *(const bf16x8*)(gl - 16 * (tau0 - 2 * sg + 1));
                    const bf16x8 B = *(const bf16x8*)(bbp + 32 * sg);
#pragma unroll
                    for (int r = 0; r < 8; ++r) acc[r] = __builtin_amdgcn_mfma_f32_16x16x32_bf16(Af[(r - 2 * u + 8) & 7], B, acc[r], 0, 0, 0);
                }
            }
#pragma unroll
            for (int r = 0; r < 8; ++r) {
                const int tb = 16 * (tau0 + r) + 4 * q4;
                const float xv[6] = {bf2f(xl[r]), bflo(xm[r].x), bfhi(xm[r].x), bflo(xm[r].y), bfhi(xm[r].y), bf2f(xr[r])};
                float rr[4];
#pragma unroll
                for (int j = 0; j < 4; ++j) rr[j] = (xw0 * xv[j] + xw1 * xv[j + 1] + xw2 * xv[j + 2] + xbs) * acc[r][j];
                u32x2 w; w.x = pk2(rr[0], rr[1]); w.y = pk2(rr[2], rr[3]);
                if (o == 0) { yst0[r] = (gi == 0) ? w : yst0[r]; yst1[r] = (gi == 1) ? w : yst1[r]; } else *(GAS1 u32x2*)((GAS1 bf16_t*)dst + tb) = w;
            }
            }
        }
    }
    BAR_LDS();
}


__device__ __forceinline__ void merge_phase(const Ctx& a, const int wvs, unsigned char* lds, int l) {
    const int tid = ltid(), lane = tid & 63, wave = tid >> 6;
    bf16_t* HyS = (bf16_t*)lds;
    const bf16_t* proj = (const bf16_t*)(a.ws + WS_PROJ);
    const bf16_t* ygelu = (const bf16_t*)(a.ws + WS_YGELU); const bf16_t* zglu = (const bf16_t*)(a.ws + WS_ZGLU);
    const bf16_t* yatt = (const bf16_t*)(a.ws + WS_YATT); const bf16_t* yrw = (const bf16_t*)(a.ws + WS_YRW);
    const float* bonus = (const float*)(a.ws + WS_BONUS); const bf16_t* vmix = (const bf16_t*)(a.ws + WS_VMIX);
    const bf16_t* yh = (const bf16_t*)(a.ws + WS_YHYT);
    bf16_t* ymix = (bf16_t*)(a.ws + WS_YMIX);
    const int TR = (l < DEPTH - 1) ? 48 : 64, RW = TR >> 3;
    const int ntile = (l < DEPTH - 1 ? TOK : TOKL) / TR;
    const int c0 = 8 * lane;
    float bg0[8], bg1[8], bg2[8], glb[8], lng[8], lnb[8];
#pragma unroll
    for (int e = 0; e < 8; ++e) {
        bg0[e] = a.in[I_BRG][(l * 3 + 0) * 512 + c0 + e]; bg1[e] = a.in[I_BRG][(l * 3 + 1) * 512 + c0 + e]; bg2[e] = a.in[I_BRG][(l * 3 + 2) * 512 + c0 + e];
        glb[e] = a.in[I_GLUB][l * 512 + c0 + e]; lng[e] = a.in[I_LNG][l * 512 + c0 + e]; lnb[e] = a.in[I_LNB][l * 512 + c0 + e];
    }
#pragma unroll 1
    for (int tile = blockIdx.x; tile < ntile; tile += gridDim.x) {
        const int row0 = tile * TR;
        BAR_LDS();
#pragma unroll
        for (int i = 0; i < 8; ++i) {
            const int tk = tid + NTHR * i; const int c = tk >> 3, rg = tk & 7;
            if (rg >= RW) continue;
            const u32x4 w = *(const u32x4*)(yh + (size_t)c * TOK + row0 + 8 * rg);
            bf16_t* d = HyS + (8 * rg) * 520 + c;
            d[0] = (bf16_t)(w.x & 0xffff); d[520] = (bf16_t)(w.x >> 16); d[2 * 520] = (bf16_t)(w.y & 0xffff); d[3 * 520] = (bf16_t)(w.y >> 16);
            d[4 * 520] = (bf16_t)(w.z & 0xffff); d[5 * 520] = (bf16_t)(w.z >> 16); d[6 * 520] = (bf16_t)(w.w & 0xffff); d[7 * 520] = (bf16_t)(w.w >> 16);
        }
        BAR_LDS();
#pragma unroll 2
        for (int rr = 0; rr < RW; ++rr) {
            const int rl = wave * RW + rr; const size_t row = (size_t)row0 + rl;
            const bf16_t* gp = proj + row * NMAIN + C_GATE + c0;
            const u32x4 L_g0 = *(const u32x4*)gp, L_g1 = *(const u32x4*)(gp + 512), L_g2 = *(const u32x4*)(gp + 1024), L_g3 = *(const u32x4*)(gp + 1536);
            const u32x4 L_yg = *(const u32x4*)(ygelu + row * 512 + c0), L_z = *(const u32x4*)(zglu + row * 512 + c0), L_ya = *(const u32x4*)(yatt + row * 512 + c0);
            const u32x4 L_r0 = *(const u32x4*)(yrw + row * 512 + c0), L_r1 = *(const u32x4*)(yrw + (size_t)TOK * 512 + row * 512 + c0), L_vm = *(const u32x4*)(vmix + row * 512 + c0);
            const int hd = lane >> 3;
            const float bon = bonus[row * 8 + hd] + bonus[(size_t)TOK * 8 + row * 8 + hd];
            const u32x4 L_hy = *(const u32x4*)(HyS + rl * 520 + c0);
            float v[8], g[8], z[8], o0[8], o1[8], o2[8];
            unpack8(L_yg, v); unpack8(L_z, z); unpack8(L_g0, g);
            float ss = 0.f;
#pragma unroll
            for (int e = 0; e < 8; ++e) { v[e] = v[e] * sigmf(z[e] + glb[e]); ss += v[e] * v[e]; }
            float rstd = __builtin_amdgcn_rsqf(wave_sum(ss) * (1.f / 512.f) + 1e-6f);
#pragma unroll
            for (int e = 0; e < 8; ++e) o0[e] = v[e] * rstd * bg0[e] * siluf(g[e]);
            unpack8(L_ya, v); unpack8(L_g1, g);
            ss = 0.f;
#pragma unroll
            for (int e = 0; e < 8; ++e) ss += v[e] * v[e];
            rstd = __builtin_amdgcn_rsqf(wave_sum(ss) * (1.f / 512.f) + 1e-6f);
#pragma unroll
            for (int e = 0; e < 8; ++e) o1[e] = v[e] * rstd * bg1[e] * siluf(g[e]);
            unpack8(L_r0, v); unpack8(L_r1, z); unpack8(L_g2, g);
            float sm = 0.f;
#pragma unroll
            for (int e = 0; e < 8; ++e) { v[e] += z[e]; sm += v[e]; }
            const float mu = sum8(sm) * (1.f / 64.f);
            float sv = 0.f;
#pragma unroll
            for (int e = 0; e < 8; ++e) { v[e] -= mu; sv += v[e] * v[e]; }
            const float rs = __builtin_amdgcn_rsqf(sum8(sv) * (1.f / 64.f) + 64e-5f);
            unpack8(L_vm, z);
#pragma unroll
            for (int e = 0; e < 8; ++e) o2[e] = (v[e] * rs * lng[e] + lnb[e] + bon * z[e]) * siluf(g[e]);
            unpack8(L_hy, v); unpack8(L_g3, g);
            ss = 0.f;
#pragma unroll
            for (int e = 0; e < 8; ++e) ss += v[e] * v[e];
            rstd = __builtin_amdgcn_rsqf(wave_sum(ss) * (1.f / 512.f) + 1e-6f);
#pragma unroll
            for (int e = 0; e < 8; ++e) v[e] = v[e] * rstd * bg2[e] * siluf(g[e]);
            *(u32x4*)(ymix + row * DM + c0) = pack8(o0);
            *(u32x4*)(ymix + row * DM + 512 + c0) = pack8(o1);
            *(u32x4*)(ymix + row * DM + 1024 + c0) = pack8(o2);
            *(u32x4*)(ymix + row * DM + 1536 + c0) = pack8(v);
        }
    }
    __syncthreads();
}

#define LAS __attribute__((address_space(3)))
#define XB_TMO      128
#define XB_XCNT(j)  (256  + 64 * (j))
#define XB_XSUB(j)  (1280 + 64 * (j))
#define XB_XGEN(j)  (2304 + 64 * (j))
#define XB_TOP      3328
#define XB_TOPGEN   3392
#define XCD_BAR_WORDS 3456
#define XB_SPIN_CAP (1u << 22)

__device__ __forceinline__ unsigned xb_ld(unsigned* p)              { return __hip_atomic_load(p, __ATOMIC_RELAXED, __HIP_MEMORY_SCOPE_AGENT); }
__device__ __forceinline__ unsigned xb_add(unsigned* p, unsigned v) { return __hip_atomic_fetch_add(p, v, __ATOMIC_RELAXED, __HIP_MEMORY_SCOPE_AGENT); }
__device__ __forceinline__ unsigned xb_xcc_id() { return (unsigned)__builtin_amdgcn_s_getreg((3 << 11) | 20) & 0xFu; }
#define XB_SPIN(cond, bar) do { unsigned _sp = 0; while (cond) { __builtin_amdgcn_s_sleep(1); \
    if ((++_sp & 255u) == 0u) { if (xb_ld(&(bar)[XB_TMO])) break; if (_sp > XB_SPIN_CAP) { atomicAdd(&(bar)[XB_TMO], 1u); break; } } } } while (0)

struct XcdBarrier {
    unsigned* bar; unsigned x;
    volatile LAS unsigned* st;
};

__device__ __forceinline__ XcdBarrier xcd_barrier_post(unsigned* bar, volatile LAS unsigned* st, const int wvs) {
    XcdBarrier b; b.bar = bar; b.x = xb_xcc_id(); b.st = st;
    if (ltid() == 0) (void)xb_add(&bar[XB_XCNT(b.x)], 1u);
    return b;
}
__device__ __forceinline__ void xcd_barrier_complete(unsigned* bar, unsigned x, unsigned& nloc, unsigned& nx) {
    const unsigned G = gridDim.x * gridDim.y * gridDim.z;
    unsigned sum, cnt, mine, sp = 0u;
    for (;;) {
        sum = 0u; cnt = 0u; mine = 0u;
#pragma unroll
        for (unsigned j = 0; j < 16; ++j) { const unsigned c = xb_ld(&bar[XB_XCNT(j)]); sum += c; cnt += (c > 0u) ? 1u : 0u; mine = (j == x) ? c : mine; }
        if (sum == G) break;
        __builtin_amdgcn_s_sleep(1);
        if ((++sp & 255u) == 0u) { if (xb_ld(&bar[XB_TMO])) break; if (sp > XB_SPIN_CAP) { atomicAdd(&bar[XB_TMO], 1u); break; } }
    }
    nloc = mine > 0u ? mine : 1u; nx = cnt > 0u ? cnt : 1u;
}

__device__ __forceinline__ void xcd_barrier(const XcdBarrier& b, const int wvs) {
    asm volatile("s_waitcnt vmcnt(0)" ::: "memory");
    __syncthreads();
    if (ltid() == 0) {
        unsigned* bar = b.bar;
        __builtin_amdgcn_s_waitcnt(0);
        unsigned nloc = b.st[0], nx = b.st[1];
        if (nloc == 0u) { xcd_barrier_complete(bar, b.x, nloc, nx); b.st[0] = nloc; b.st[1] = nx; }
        const unsigned old = xb_add(&bar[XB_XSUB(b.x)], 1u);
        const unsigned gen = old / nloc;
        if (old + 1u == (gen + 1u) * nloc) {
            __builtin_amdgcn_fence(__ATOMIC_RELEASE, "agent");
            asm volatile("s_waitcnt vmcnt(0)" ::: "memory");
            const unsigned og = xb_add(&bar[XB_TOP], 1u);
            const unsigned tg = og / nx;
            if (og + 1u == (tg + 1u) * nx) xb_add(&bar[XB_TOPGEN], 1u);
            else XB_SPIN(xb_ld(&bar[XB_TOPGEN]) == tg, bar);
            __builtin_amdgcn_fence(__ATOMIC_ACQUIRE, "agent");
            xb_add(&bar[XB_XGEN(b.x)], 1u);
            asm volatile("s_waitcnt vmcnt(0)" ::: "memory");
        } else {
            XB_SPIN(xb_ld(&bar[XB_XGEN(b.x)]) == gen, bar);
            __builtin_amdgcn_fence(__ATOMIC_ACQUIRE, "agent");
            asm volatile("s_waitcnt vmcnt(0)" ::: "memory");
        }
    }
    __syncthreads();
}


__device__ __forceinline__ unsigned char* launder(unsigned char* p) { GAS1 unsigned char* q = (GAS1 unsigned char*)p; asm volatile("" : "+s"(q)); return (unsigned char*)q; }
#define MKCTX() Ctx a; { unsigned char* w_ = as_global(launder(ka.ws)); a.ws = w_; a.in.t = (const float* const*)(w_ + WS_TAB); a.out = (float*)(a.in[N_IN]); }
__global__ void __launch_bounds__(NTHR, 2) fwd_mega(Args ka) {
    extern __shared__ __attribute__((aligned(16))) unsigned char lds[];
    const int wvs = __builtin_amdgcn_readfirstlane((int)threadIdx.x >> 6);
    const int tid = ltid();
    const int G = gridDim.x, bid = blockIdx.x;
    PG8_LAS unsigned char* glds = (PG8_LAS unsigned char*)lds;
    if (tid == 0) {
        const float** tab = (const float**)(launder(ka.ws) + WS_TAB);
#define TW(i) tab[i] = ka.in[i];
        TW(0) TW(1) TW(2) TW(3) TW(4) TW(5) TW(6) TW(7) TW(8) TW(9) TW(10) TW(11) TW(12) TW(13) TW(14) TW(15) TW(16) TW(17) TW(18) TW(19) TW(20) TW(21)
        TW(22) TW(23) TW(24) TW(25) TW(26) TW(27) TW(28) TW(29) TW(30) TW(31) TW(32) TW(33) TW(34) TW(35) TW(36) TW(37) TW(38) TW(39) TW(40) TW(41) TW(42) TW(43)
#undef TW
        tab[N_IN] = (const float*)ka.out;
        __threadfence();
    }
    volatile LAS unsigned* xst = (volatile LAS unsigned*)((LAS unsigned char*)lds + (LDS_BYTES - 64));
    if (tid < 2) xst[tid] = 0u;
    __syncthreads();
    cg::this_grid().sync();
    XcdBarrier xbar = xcd_barrier_post((unsigned*)(ka.ws + WS_BAR), xst, wvs);
#ifndef NO_P0
    { MKCTX(); for (int rep = 0; rep < REP_P0; ++rep) phase0(a, wvs, lds); }
#endif
    GSYNC();
#pragma unroll 1
    for (int l = 0; l < DEPTH; ++l) {
        const bool ctx_out = l < DEPTH - 1;
#ifndef NO_NORM
        { MKCTX(); for (int rep = 0; rep < REP_CONV; ++rep) convert_weights(a, wvs, lds, l); for (int rep = 0; rep < REP_NORM; ++rep) norm_phase(a, wvs, l); }
#endif
        GSYNC();
        {
            unsigned char* ws = as_global(launder(ka.ws));
            const int mrows = ctx_out ? TOK : TOKL;
            pg8::Gemm g{(const bf16_t*)(ws + WS_H), (const bf16_t*)(ws + WS_WTMAIN), mrows, NMAIN, DM, nullptr, nullptr};
            pg8::StaticOrder S; S.init(mrows, NMAIN, G, bid);
            pg8::EpiBf16<0> E{(bf16_t*)(ws + WS_PROJ), NMAIN, nullptr, 0, 0, 1.f, nullptr, 0};
            for (int rep = 0; rep < REP_INPROJ; ++rep) pg8::gemm_phase<pg8::EpiBf16<0>, pg8::StaticOrder, true, true>(glds, g, S, E, wvs);
        }
        {
            unsigned char* ws = as_global(launder(ka.ws));
            const int crows = ctx_out ? 0 : TOKC;
            pg8::Gemm g{(const bf16_t*)(ws + WS_H) + (size_t)TOKL * DM, (const bf16_t*)(ws + WS_WTMAIN), crows, 3072, DM, nullptr, nullptr};
            pg8::StaticOrder S; S.init(crows, 3072, G, bid);
            pg8::EpiBf16<0> E{(bf16_t*)(ws + WS_PROJ) + (size_t)TOKL * NMAIN, NMAIN, nullptr, 0, 0, 1.f, nullptr, 0};
            pg8::gemm_phase<pg8::EpiBf16<0>, pg8::StaticOrder, true, true>(glds, g, S, E, wvs);
        }
        {
            unsigned char* ws = as_global(launder(ka.ws));
            const int ntok = ctx_out ? TOK : TOKL;
            pg8::Gemm g{(const bf16_t*)(ws + WS_WTHY), (const bf16_t*)(ws + WS_H), 1536, ntok, DM, nullptr, nullptr};
            pg8::StaticOrder S; S.init(1536, ntok, G, (bid + (G >> 1)) % G);
            pg8::EpiBf16<0> E{(bf16_t*)(ws + WS_HYT), TOK, nullptr, 0, 0, 1.f, nullptr, 0};
            for (int rep = 0; rep < REP_HYPROJ; ++rep) pg8::gemm_phase<pg8::EpiBf16<0>, pg8::StaticOrder, true, true>(glds, g, S, E, wvs);
        }
        GSYNC();
        {
#ifndef NO_RWKV
        { MKCTX();
        for (int rep = 0; rep < REP_RWKV; ++rep) for (int it = bid; it < 256; it += G) rwkv_chain(a, wvs, lds, l, it >> 4, (it >> 1) & 7, it & 1); }
#endif
#ifndef NO_S5
        { MKCTX();
        for (int rep = 0; rep < REP_S5; ++rep) for (int it = bid; it < 256; it += G) {
            const int wv = wvs;
            if (wv < 4) { const int pr = 2 * it + (wv >> 1); s5_chain(a, wvs, lds + wv * 25088, l, pr >> 5, pr & 31, wv & 1); }
            __builtin_amdgcn_fence(__ATOMIC_RELEASE, "workgroup"); __syncthreads(); __builtin_amdgcn_fence(__ATOMIC_ACQUIRE, "workgroup");
            s5_combine(a, wvs, l, 2 * it);
        } }
#endif
        __syncthreads();
#ifndef NO_ATT
        { MKCTX();
        for (int rep = 0; rep < REP_ATT; ++rep) for (int it = bid; it < 1024 + (ctx_out ? 128 : 0); it += G) {
            if (it < 1024) attn_unit(a, wvs, lds, l, it >> 6, it & 3, (it >> 2) & 15, false);
            else { const int r = it - 1024; attn_unit(a, wvs, lds, l, r >> 3, r & 3, (r >> 2) & 1, true); }
        } }
#endif
        __syncthreads();
#ifndef NO_HY
        { MKCTX();
        for (int rep = 0; rep < REP_HY; ++rep) for (int it = bid; it < 512 * (ctx_out ? 2 : 1); it += G) hyena_item(a, wvs, lds, l, it & 511, it >= 512); }
#endif
        }
        GSYNC();
        {
            unsigned char* ws = as_global(launder(ka.ws));
            const int ntok = ctx_out ? TOK : TOKL;
            pg8::Gemm g{(const bf16_t*)(ws + WS_YGELU), (const bf16_t*)(ws + WS_WTGLU), ntok, 512, 512, nullptr, nullptr};
            pg8::StaticOrder S; S.init(ntok, 512, G, bid);
            pg8::EpiBf16<0> E{(bf16_t*)(ws + WS_ZGLU), 512, nullptr, 0, 0, 1.f, nullptr, 0};
            for (int rep = 0; rep < REP_GLU; ++rep) pg8::gemm_phase<pg8::EpiBf16<0>, pg8::StaticOrder, true, true>(glds, g, S, E, wvs);
        }
        GSYNC();
#ifndef NO_MERGE
        { MKCTX(); for (int rep = 0; rep < REP_MERGE; ++rep) merge_phase(a, wvs, lds, l); }
#endif
        GSYNC();
        {
            MKCTX(); unsigned char* ws = a.ws;
            const int ntok = ctx_out ? TOK : TOKL;
            pg8::Gemm g{(const bf16_t*)(ws + WS_YMIX), (const bf16_t*)(ws + WS_WTOUT), ntok, DM, DM, nullptr, nullptr};
            pg8::StaticOrder S; S.init(ntok, DM, G, bid);
            EpiResid E{l == 0 ? a.in[I_X] : a.out, l == 0 ? a.in[I_CTX] : (const float*)(ws + WS_XC), a.out, (float*)(ws + WS_XC), (const float*)(ws + WS_MOD) + (size_t)l * 17 * 6144};
            pg8::gemm_phase<EpiResid, pg8::StaticOrder, true, true>(glds, g, S, E, wvs);
        }
        GSYNC();
    }
}

extern "C" void kernel_launch(void* const* d_in, const int* in_sizes, int n_in, void* d_out, int out_size, void* d_ws, size_t ws_size, hipStream_t stream) {
    static int grid = 0;
    if (grid == 0) {
        if (n_in != N_IN || ws_size < WS_END) { fprintf(stderr, "kernel_launch: unexpected inputs (n_in %d, ws %zu, need %zu)\n", n_in, ws_size, (size_t)WS_END); grid = -1; return; }
        int dev = 0, cus = 0, per_cu = 0;
        hipGetDevice(&dev);
        hipDeviceGetAttribute(&cus, hipDeviceAttributeMultiprocessorCount, dev);
        if (hipFuncSetAttribute((const void*)fwd_mega, hipFuncAttributeMaxDynamicSharedMemorySize, LDS_BYTES) != hipSuccess) { fprintf(stderr, "kernel_launch: hipFuncSetAttribute failed\n"); grid = -1; return; }
        if (hipOccupancyMaxActiveBlocksPerMultiprocessor(&per_cu, (const void*)fwd_mega, NTHR, LDS_BYTES) != hipSuccess || per_cu < 1) { fprintf(stderr, "kernel_launch: occupancy query says %d\n", per_cu); per_cu = 1; }
        (void)hipGetLastError();
        grid = cus * 1;
    }
    if (grid < 0) return;
    if (hipMemsetAsync((char*)d_ws + WS_BAR, 0, 16384, stream) != hipSuccess) { fprintf(stderr, "kernel_launch: memset failed\n"); return; }
    Args a{};
    for (int i = 0; i < N_IN; ++i) a.in[i] = (const float*)d_in[i];
    a.out = (float*)d_out; a.ws = (unsigned char*)d_ws;
    void* args[] = {&a};
    hipError_t e = hipLaunchCooperativeKernel((const void*)fwd_mega, dim3(grid), dim3(NTHR), args, LDS_BYTES, stream);
    if (e != hipSuccess) fprintf(stderr, "cooperative launch failed: %s (grid %d)\n", hipGetErrorString(e), grid);
}
```

```cpp
#include <hip/hip_runtime.h>
#include <hip/hip_cooperative_groups.h>
#include <cstdio>
#include <cstdint>
namespace cg = cooperative_groups;
namespace pg8 {
#define PG8_LAS __attribute__((address_space(3)))
typedef unsigned short bf16_t;
typedef short bf16x8 __attribute__((ext_vector_type(8)));
typedef float f32x4 __attribute__((ext_vector_type(4)));
typedef unsigned u32x4 __attribute__((ext_vector_type(4)));
constexpr int BM = 256, BK = 64, HALF = 128, HTB = HALF * BK * 2  , STAGE_BYTES = 8 * HTB, NXCD = 8, WGM = 8;

__host__ __device__ __forceinline__ int lds_byte(int r, int c) { const int st = (r >> 4) * 2 + (c >> 5), rr = r & 15, cc = c & 31, ob = rr * 64 + cc * 2; return st * 1024 + (ob ^ (((ob >> 9) & 1) << 5)); }
__host__ __device__ __forceinline__ void stage_rc(int b, int& R, int& C) { const int st = b / 1024, sb = b % 1024, swz = sb ^ (((sb >> 9) & 1) << 5); R = (st >> 1) * 16 + swz / 64; C = (st & 1) * 32 + (swz % 64) / 2; }
__host__ __device__ __forceinline__ int perm32(int rho) { const int n = rho >> 4, i = rho & 15; return 8 * (i >> 2) + 4 * n + (i & 3); }

struct Unit { int pm, pn, w; };
struct Gemm { const bf16_t* A; const bf16_t* Bt; int M, N, K; const bf16_t* A2; const bf16_t* Bt2; };

struct StaticOrder {
    int nM, nN, nwg, G, c;
    __host__ __device__ void init(int M, int N, int G_, int c_) { nM = M / BM; nN = N / BM; nwg = nM * nN; G = G_; c = c_; }
    __host__ __device__ bool next(int i, Unit& u) const {
        const long L = (long)i * G + c; if (L >= nwg) return false;
        int wgid = (int)L; { const int q = nwg / NXCD, r = nwg % NXCD, xcd = wgid % NXCD, off = wgid / NXCD; wgid = (xcd < r ? xcd * (q + 1) : r * (q + 1) + (xcd - r) * q) + off; }
        const int nig = WGM * nN, gid = wgid / nig, fm = gid * WGM, gsz = (nM - fm) < WGM ? (nM - fm) : WGM;
        u.pm = fm + ((wgid % nig) % gsz); u.pn = (wgid % nig) / gsz; u.w = 0; return true;
    }
    __device__ __forceinline__ void a_ready(const Unit&) const {}
    __device__ __forceinline__ void done(const Unit&) const {}
};

struct DualOrder {
    int nM0, nN0, nwg0, nM1, nN1, nwg1, G, c;
    __host__ __device__ void init(int M0, int N0, int M1, int N1, int G_, int c_) { nM0 = M0 / BM; nN0 = N0 / BM; nwg0 = nM0 * nN0; nM1 = M1 / BM; nN1 = N1 / BM; nwg1 = nM1 * nN1; G = G_; c = c_; }
    __host__ __device__ bool next(int i, Unit& u) const {
        long L = (long)i * G + c; if (L >= nwg0 + nwg1) return false;
        const int w = L >= nwg0; if (w) L -= nwg0;
        const int nM = w ? nM1 : nM0, nN = w ? nN1 : nN0, nwg = w ? nwg1 : nwg0;
        int wgid = (int)L; { const int q = nwg / NXCD, r = nwg % NXCD, xcd = wgid % NXCD, off = wgid / NXCD; wgid = (xcd < r ? xcd * (q + 1) : r * (q + 1) + (xcd - r) * q) + off; }
        const int nig = WGM * nN, gid = wgid / nig, fm = gid * WGM, gsz = (nM - fm) < WGM ? (nM - fm) : WGM;
        u.pm = fm + ((wgid % nig) % gsz); u.pn = (wgid % nig) / gsz; u.w = w; return true;
    }
    __device__ __forceinline__ void a_ready(const Unit&) const {}
    __device__ __forceinline__ void done(const Unit&) const {}
};

__device__ __forceinline__ unsigned cvt_pk_bf16(float lo, float hi) { unsigned r; asm volatile("v_cvt_pk_bf16_f32 %0, %1, %2" : "=v"(r) : "v"(lo), "v"(hi)); return r; }
typedef float f32x2 __attribute__((ext_vector_type(2)));
__device__ __forceinline__ f32x2 gelu_pk(f32x2 v) {
    const f32x2 av = __builtin_elementwise_abs(v), d = av * 0.2316418882f + 1.0f;
    f32x2 t; t.x = __builtin_amdgcn_rcpf(d.x); t.y = __builtin_amdgcn_rcpf(d.y);
    f32x2 q = t * 0.5307027145f + (-0.7265760135f); q = q * t + 0.7107068705f; q = q * t + (-0.142248368f); q = q * t + 0.127414796f; q = q * t;
    const f32x2 s = (v * v) * (-0.72134752044f);
    f32x2 e; e.x = __builtin_amdgcn_exp2f(s.x); e.y = __builtin_amdgcn_exp2f(s.y);
    const f32x2 m = v * (q * e), r = v - m;
    f32x2 o; o.x = v.x < 0.f ? m.x : r.x; o.y = v.y < 0.f ? m.y : r.y; return o;
}

template <int ACT  > struct EpiBf16 {
    static constexpr bool PERM = true, AFTER_DRAIN = false; static_assert(ACT == 0 || ACT == 1, "EpiBf16: ACT is 0 (none) or 1 (gelu_pk)");
    bf16_t* O; int ldc; const float* bias; int split_cols; size_t split_stride; float scale0; bf16_t* O2; int ldc2;
    __device__ __forceinline__ void operator()(const f32x4 (&acc)[2][2][4][2], const Unit& u, int wr, int wc, int fr, int fq) const {
        const int row0 = u.pm * BM + wr * 64 + fr; int colt = u.pn * BM; bf16_t* base = u.w ? O2 : O; const int ldc = u.w ? ldc2 : this->ldc;
        float sc = 1.f; if (split_cols) { const int t = colt / split_cols; base += (size_t)t * split_stride; colt -= t * split_cols; if (t == 0) sc = scale0; }
        const int col0 = colt + wc * 32 + 8 * fq, bcol0 = u.pn * BM + wc * 32 + 8 * fq;
        f32x4 bv[2][2];
#pragma unroll
        for (int bj = 0; bj < 2; ++bj)
#pragma unroll
            for (int n = 0; n < 2; ++n) bv[bj][n] = bias ? *(const f32x4*)(bias + bcol0 + bj * HALF + 4 * n) : (f32x4){0.f, 0.f, 0.f, 0.f};
#pragma unroll
        for (int ai = 0; ai < 2; ++ai)
#pragma unroll
            for (int m = 0; m < 4; ++m) { bf16_t* rowp = base + (size_t)(row0 + ai * HALF + m * 16) * ldc + col0;
#pragma unroll
                for (int bj = 0; bj < 2; ++bj) { f32x4 v0 = acc[ai][bj][m][0] + bv[bj][0], v1 = acc[ai][bj][m][1] + bv[bj][1];
                    if (ACT == 1) { f32x2 a = gelu_pk((f32x2){v0[0], v0[1]}), b = gelu_pk((f32x2){v0[2], v0[3]}), c = gelu_pk((f32x2){v1[0], v1[1]}), d = gelu_pk((f32x2){v1[2], v1[3]});
                        v0 = (f32x4){a.x, a.y, b.x, b.y}; v1 = (f32x4){c.x, c.y, d.x, d.y}; }
                    v0 = v0 * sc; v1 = v1 * sc; u32x4 w; w.x = cvt_pk_bf16(v0[0], v0[1]); w.y = cvt_pk_bf16(v0[2], v0[3]); w.z = cvt_pk_bf16(v1[0], v1[1]); w.w = cvt_pk_bf16(v1[2], v1[3]);
                    *(u32x4*)(rowp + bj * HALF) = w; } }
    }
};

template <class Epi, class Sched, bool ALIGN_EPI = false, bool SP2 = false>
__device__ __forceinline__ void gemm_phase(PG8_LAS unsigned char* lds, const Gemm g, const Sched& S, const Epi& E, const int wvs) {
    int tid = wvs * 64 + (int)__builtin_amdgcn_mbcnt_hi(~0u, __builtin_amdgcn_mbcnt_lo(~0u, 0u)); asm volatile("" : "+v"(tid)); const int wid = __builtin_amdgcn_readfirstlane(tid >> 6), lane = tid & 63, wr = wid >> 2, wc = wid & 3, fr = lane & 15, fq = lane >> 4;
    const int K = g.K, nt = K / BK;
    unsigned voffA[2], voffB[2];
#pragma unroll
    for (int i = 0; i < 2; ++i) { int R, C; stage_rc(tid * 16 + i * 8192, R, C); const int Rb = Epi::PERM ? ((R & ~31) + perm32(R & 31)) : R;
        voffA[i] = (unsigned)(R * K + C) * 2u; voffB[i] = (unsigned)(Rb * K + C) * 2u; }
    const size_t kstep = (size_t)(BK * 2);
    const size_t hstep = (size_t)HALF * K * 2;
    const size_t tstep = 2 * hstep;
    const unsigned ldsw = (unsigned)wid * 1024u;
    const int aoff = lds_byte(wr * 64 + fr, fq * 8), boff = lds_byte(wc * 32 + fr, fq * 8);
#define PG8_SA(b, h) (((b) * 2 + (h)) * HTB)
#define PG8_SB(b, h) ((4 + (b) * 2 + (h)) * HTB)
#define PG8_STAGE(bufoff, gbase, voff) do { _Pragma("unroll") for (int _i = 0; _i < 2; ++_i) \
        __builtin_amdgcn_global_load_lds((const unsigned*)((const char*)(gbase) + (voff)[_i]), (PG8_LAS unsigned*)(lds + (bufoff) + ldsw + _i * 8192), 16, 0, 0); } while (0)
#define PG8_LDA(dst, b, h) do { _Pragma("unroll") for (int m = 0; m < 4; ++m) _Pragma("unroll") for (int k = 0; k < 2; ++k) dst[m][k] = *(const PG8_LAS bf16x8*)(lds + PG8_SA(b, h) + aoff + m * 2048 + k * 1024); } while (0)
#define PG8_LDB(dst, b, h) do { _Pragma("unroll") for (int n = 0; n < 2; ++n) _Pragma("unroll") for (int k = 0; k < 2; ++k) dst[n][k] = *(const PG8_LAS bf16x8*)(lds + PG8_SB(b, h) + boff + n * 2048 + k * 1024); } while (0)
#define PG8_MMA(ai, bj, At, Bt) do { __builtin_amdgcn_s_setprio(1); _Pragma("unroll") for (int m = 0; m < 4; ++m) _Pragma("unroll") for (int n = 0; n < 2; ++n) _Pragma("unroll") for (int k = 0; k < 2; ++k) \
        acc[ai][bj][m][n] = __builtin_amdgcn_mfma_f32_16x16x32_bf16(Bt[n][k], At[m][k], acc[ai][bj][m][n], 0, 0, 0); __builtin_amdgcn_s_setprio(0); } while (0)
#define PG8_WAIT_V(n) asm volatile("s_waitcnt vmcnt(" #n ")" ::: "memory")
#define PG8_WAIT_L(n) asm volatile("s_waitcnt lgkmcnt(" #n ")" ::: "memory")
#define PG8_BAR __builtin_amdgcn_s_barrier()
#define PG8_SCHED __builtin_amdgcn_sched_barrier(0)
    Unit cur, nxt; int ui = 0;
    if (!S.next(0, cur)) return;
    f32x4 acc[2][2][4][2];
#pragma unroll
    for (int a = 0; a < 2; ++a)
#pragma unroll
        for (int b = 0; b < 2; ++b)
#pragma unroll
            for (int m = 0; m < 4; ++m)
#pragma unroll
                for (int n = 0; n < 2; ++n) acc[a][b][m][n] = (f32x4){0.f, 0.f, 0.f, 0.f};
    bf16x8 At[4][2], B0[2][2], B1[2][2];
    const char* cA = (const char*)(cur.w ? g.A2 : g.A) + (size_t)cur.pm * tstep; const char* cB = (const char*)(cur.w ? g.Bt2 : g.Bt) + (size_t)cur.pn * tstep;
    S.a_ready(cur);
    if constexpr (SP2) {
        PG8_STAGE(PG8_SB(0, 0), cB, voffB); PG8_STAGE(PG8_SB(0, 1), cB + hstep, voffB); PG8_STAGE(PG8_SA(0, 0), cA, voffA); PG8_STAGE(PG8_SA(0, 1), cA + hstep, voffA);
        if (wr == 1) PG8_BAR;
        PG8_WAIT_V(2); PG8_BAR;
        PG8_STAGE(PG8_SB(1, 0), cB + kstep, voffB); PG8_STAGE(PG8_SA(1, 0), cA + kstep, voffA); PG8_STAGE(PG8_SB(1, 1), cB + hstep + kstep, voffB);
        PG8_WAIT_V(6); PG8_BAR;
    } else {
        PG8_STAGE(PG8_SB(0, 0), cB, voffB); PG8_STAGE(PG8_SA(0, 0), cA, voffA); PG8_STAGE(PG8_SB(0, 1), cB + hstep, voffB); PG8_STAGE(PG8_SA(0, 1), cA + hstep, voffA);
        if (wr == 1) PG8_BAR;
        PG8_WAIT_V(4); PG8_BAR;
        PG8_STAGE(PG8_SB(1, 0), cB + kstep, voffB); PG8_STAGE(PG8_SA(1, 0), cA + kstep, voffA); PG8_STAGE(PG8_SB(1, 1), cB + hstep + kstep, voffB);
        PG8_WAIT_V(6); PG8_BAR;
    }
    for (;;) {
        const bool has_next = S.next(ui + 1, nxt);
        const char* nA = has_next ? (const char*)(nxt.w ? g.A2 : g.A) + (size_t)nxt.pm * tstep : cA; const char* nB = has_next ? (const char*)(nxt.w ? g.Bt2 : g.Bt) + (size_t)nxt.pn * tstep : cB;
        for (int t = 0; t < nt; t += 2) {
            const bool last = (t == nt - 2);
            const char* a1 = cA + (size_t)(t + 1) * kstep;
            const char* a2 = last ? nA : cA + (size_t)(t + 2) * kstep; const char* b2 = last ? nB : cB + (size_t)(t + 2) * kstep;
            const char* a3 = a2 + kstep; const char* b3 = b2 + kstep;
            if (last && has_next) S.a_ready(nxt);
            if constexpr (SP2) {
            PG8_LDB(B0, 0, 0); PG8_LDB(B1, 0, 1); PG8_SCHED; PG8_LDA(At, 0, 0); PG8_STAGE(PG8_SA(1, 1), a1 + hstep, voffA);
            PG8_WAIT_V(8); PG8_WAIT_L(0); PG8_BAR; PG8_MMA(0, 0, At, B0); PG8_MMA(0, 1, At, B1); PG8_BAR; PG8_SCHED;
            PG8_LDA(At, 0, 1); PG8_STAGE(PG8_SB(0, 0), b2, voffB); PG8_STAGE(PG8_SB(0, 1), b2 + hstep, voffB); PG8_STAGE(PG8_SA(0, 0), a2, voffA);
            PG8_WAIT_V(8); PG8_WAIT_L(0); PG8_BAR; PG8_MMA(1, 0, At, B0); PG8_MMA(1, 1, At, B1); PG8_BAR; PG8_SCHED;
            PG8_LDB(B0, 1, 0); PG8_LDB(B1, 1, 1); PG8_SCHED; PG8_LDA(At, 1, 0); PG8_STAGE(PG8_SA(0, 1), a2 + hstep, voffA);
            PG8_WAIT_V(8); PG8_WAIT_L(0); PG8_BAR; PG8_MMA(0, 0, At, B0); PG8_MMA(0, 1, At, B1); PG8_BAR; PG8_SCHED;
            PG8_LDA(At, 1, 1); PG8_STAGE(PG8_SB(1, 0), b3, voffB); PG8_STAGE(PG8_SB(1, 1), b3 + hstep, voffB); PG8_STAGE(PG8_SA(1, 0), a3, voffA);
            PG8_WAIT_V(8); PG8_WAIT_L(0); PG8_BAR; PG8_MMA(1, 0, At, B0); PG8_MMA(1, 1, At, B1); PG8_BAR; PG8_SCHED;
            } else {
            PG8_LDB(B0, 0, 0); PG8_SCHED; PG8_LDA(At, 0, 0); PG8_STAGE(PG8_SA(1, 1), a1 + hstep, voffA);
            PG8_WAIT_L(8); PG8_BAR; PG8_WAIT_L(0); PG8_MMA(0, 0, At, B0); PG8_BAR; PG8_SCHED;
            PG8_LDB(B1, 0, 1); PG8_STAGE(PG8_SB(0, 0), b2, voffB);
            PG8_BAR; PG8_WAIT_L(0); PG8_MMA(0, 1, At, B1); PG8_BAR;
            PG8_LDA(At, 0, 1); PG8_STAGE(PG8_SA(0, 0), a2, voffA);
            PG8_BAR; PG8_WAIT_L(0); PG8_MMA(1, 0, At, B0); PG8_BAR; PG8_SCHED;
            PG8_STAGE(PG8_SB(0, 1), b2 + hstep, voffB);
            PG8_WAIT_V(6); PG8_BAR; PG8_MMA(1, 1, At, B1); PG8_BAR;
            PG8_LDB(B0, 1, 0); PG8_SCHED; PG8_LDA(At, 1, 0); PG8_STAGE(PG8_SA(0, 1), a2 + hstep, voffA);
            PG8_WAIT_L(8); PG8_BAR; PG8_WAIT_L(0); PG8_MMA(0, 0, At, B0); PG8_BAR; PG8_SCHED;
            PG8_LDB(B1, 1, 1); PG8_STAGE(PG8_SB(1, 0), b3, voffB);
            PG8_BAR; PG8_WAIT_L(0); PG8_MMA(0, 1, At, B1); PG8_BAR;
            PG8_LDA(At, 1, 1); PG8_STAGE(PG8_SA(1, 0), a3, voffA);
            PG8_BAR; PG8_WAIT_L(0); PG8_MMA(1, 0, At, B0); PG8_BAR; PG8_SCHED;
            PG8_STAGE(PG8_SB(1, 1), b3 + hstep, voffB);
            PG8_WAIT_V(6); PG8_BAR; PG8_MMA(1, 1, At, B1); PG8_BAR;
            }
        }
        if constexpr (ALIGN_EPI) { if (wr == 0) PG8_BAR; }
        if constexpr (!Epi::AFTER_DRAIN) { E(acc, cur, wr, wc, fr, fq); S.done(cur); }
        if (!has_next) break;
#pragma unroll
        for (int a = 0; a < 2; ++a)
#pragma unroll
            for (int b = 0; b < 2; ++b)
#pragma unroll
                for (int m = 0; m < 4; ++m)
#pragma unroll
                    for (int n = 0; n < 2; ++n) acc[a][b][m][n] = (f32x4){0.f, 0.f, 0.f, 0.f};
        cur = nxt; cA = nA; cB = nB; ++ui;
        if constexpr (ALIGN_EPI) { if (wr == 1) PG8_BAR; }
    }
    PG8_WAIT_V(0);
    if constexpr (!ALIGN_EPI) { if (wr == 0) PG8_BAR; }
    PG8_BAR;
    if constexpr (Epi::AFTER_DRAIN) { E.fused(acc, cur, wr, wc, fr, fq, lds, wid, lane); S.done(cur); }
#undef PG8_SA
#undef PG8_SB
#undef PG8_STAGE
#undef PG8_LDA
#undef PG8_LDB
#undef PG8_MMA
#undef PG8_WAIT_V
#undef PG8_WAIT_L
#undef PG8_BAR
#undef PG8_SCHED
}
}
typedef unsigned short bf16_t;
typedef short bf16x8 __attribute__((ext_vector_type(8)));
typedef float f32x4 __attribute__((ext_vector_type(4)));
typedef float f32x16 __attribute__((ext_vector_type(16)));
typedef unsigned u32x4 __attribute__((ext_vector_type(4)));
typedef unsigned u32x2 __attribute__((ext_vector_type(2)));

constexpr int NB = 16, SEQ = 2048, DM = 2048, DEPTH = 4, CTXL = 256;
constexpr int TOKL = NB * SEQ, TOKC = NB * CTXL, TOK = TOKL + TOKC;
constexpr int DIN = 6528, NMAIN = 5120;
constexpr int C_S5 = 0, C_Q = 512, C_K = 1024, C_V = 1152, C_RKV = 1280, C_LORA = 2816, C_GATE = 2944;
constexpr int SRC_HY = 2944, SRC_GATE = 4480;
constexpr int NTHR = 512;
constexpr int LDS_BYTES = 147456;

constexpr size_t WS_TAB = 0;
constexpr size_t WS_BAR = 4096;
constexpr size_t WS_WTMAIN = 4096 + 16384;
constexpr size_t WS_WTHY   = WS_WTMAIN + (size_t)NMAIN * DM * 2;
constexpr size_t WS_WTOUT  = WS_WTHY + (size_t)1536 * DM * 2;
constexpr size_t WS_WTGLU  = WS_WTOUT + (size_t)DM * DM * 2;
constexpr size_t WS_MOD    = WS_WTGLU + (size_t)512 * 512 * 2;
constexpr size_t WS_ROPE   = WS_MOD + (size_t)DEPTH * 17 * 6144 * 4;
constexpr size_t WS_S5LB   = WS_ROPE + 16384;
constexpr size_t WS_S5BB   = WS_S5LB + (size_t)DEPTH * 2 * 32 * 64 * 2 * 4;
constexpr size_t WS_GF     = WS_S5BB + (size_t)DEPTH * 2 * 32 * 64 * 16 * 2 * 4;
constexpr size_t WS_GFC    = WS_GF + (size_t)DEPTH * 2 * 512 * 4096 * 2;
constexpr size_t WS_H      = WS_GFC + (size_t)DEPTH * 2 * 512 * 512 * 2;
constexpr size_t WS_YSF    = WS_H;
constexpr size_t WS_Y1     = WS_H + (size_t)TOK * 512 * 4;
constexpr size_t WS_YMIX   = WS_H;
constexpr size_t WS_PROJ   = WS_H + (size_t)TOK * DM * 2;
constexpr size_t WS_HYT    = WS_PROJ + (size_t)TOK * NMAIN * 2;
constexpr size_t WS_ZGLU   = WS_HYT;
constexpr size_t WS_YGELU  = WS_HYT + (size_t)1536 * TOK * 2;
constexpr size_t WS_YATT   = WS_YGELU + (size_t)TOK * 512 * 2;
constexpr size_t WS_YRW    = WS_YATT + (size_t)TOK * 512 * 2;
constexpr size_t WS_BONUS  = WS_YRW + (size_t)2 * TOK * 512 * 2;
constexpr size_t WS_VMIX   = WS_BONUS + (size_t)2 * TOK * 8 * 4;
constexpr size_t WS_YHYT   = WS_VMIX + (size_t)TOK * 512 * 2;
constexpr size_t WS_XC     = WS_YHYT + (size_t)512 * TOK * 2;
constexpr size_t WS_YSB    = WS_XC + (size_t)TOKC * DM * 4;
constexpr size_t WS_END    = WS_YSB + (size_t)TOK * 512 * 4;
static_assert(WS_END <= 1070000000ull, "workspace budget");

enum { I_X = 0, I_C, I_CTX, I_CCTX, I_NORMG, I_WADA, I_BADA, I_WIN, I_WOUT, I_BRG, I_LRE, I_LIM, I_LSTEP, I_BRE, I_BIM, I_CRE, I_CIM, I_S5D,
       I_GLUW, I_GLUB, I_QG, I_KG, I_SINK, I_MUP, I_MUN, I_W0, I_W2, I_A0, I_A2, I_KK, I_KA, I_RK, I_LNG, I_LNB, I_HCW, I_HCB, I_HW1, I_HB1, I_HF1,
       I_HW2, I_HB2, I_HF2, I_HW3, I_HSKIP, N_IN };

struct Args { const float* in[N_IN]; float* out; unsigned char* ws; };
#define GAS1 __attribute__((address_space(1)))
template <class T> __device__ __forceinline__ T* as_global(T* p) { return (T*)(GAS1 T*)p; }
struct InTab { const float* const* t; __device__ __forceinline__ const float* operator[](int i) const { return (const float*)(((GAS1 const float* GAS1 const*)t)[i]); } };
struct Ctx { InTab in; float* out; unsigned char* ws; };
constexpr size_t WS_TAB_BYTES = 4096;

__device__ __forceinline__ float bf2f(unsigned v) { return __uint_as_float(v << 16); }
__device__ __forceinline__ unsigned f2bf(float f) { unsigned u = __float_as_uint(f); return (u + 0x7fffu + ((u >> 16) & 1u)) >> 16; }
__device__ __forceinline__ unsigned pk2(float lo, float hi) { return f2bf(lo) | (f2bf(hi) << 16); }
__device__ __forceinline__ float bflo(unsigned w) { return __uint_as_float(w << 16); }
__device__ __forceinline__ float bfhi(unsigned w) { return __uint_as_float(w & 0xffff0000u); }
__device__ __forceinline__ int ltid_(int wvs) { int t = wvs * 64 + (int)__builtin_amdgcn_mbcnt_hi(~0u, __builtin_amdgcn_mbcnt_lo(~0u, 0u)); asm volatile("" : "+v"(t)); return t; }
#define ltid() ltid_(wvs)
#define BAR_LDS() asm volatile("s_waitcnt lgkmcnt(0)\n\ts_barrier" ::: "memory")
#define LDS_WAIT() asm volatile("s_waitcnt lgkmcnt(0)" ::: "memory")
template <int CTRL> __device__ __forceinline__ float dppf(float x) { return __builtin_bit_cast(float, __builtin_amdgcn_mov_dpp(__builtin_bit_cast(int, x), CTRL, 0xf, 0xf, true)); }
__device__ __forceinline__ float wave_sum(float v) {
    v += dppf<0xB1>(v); v += dppf<0x4E>(v); v += dppf<0x141>(v); v += dppf<0x140>(v);
    const int iv = __builtin_bit_cast(int, v);
    const float r0 = __builtin_bit_cast(float, __builtin_amdgcn_readlane(iv, 0)), r1 = __builtin_bit_cast(float, __builtin_amdgcn_readlane(iv, 16));
    const float r2 = __builtin_bit_cast(float, __builtin_amdgcn_readlane(iv, 32)), r3 = __builtin_bit_cast(float, __builtin_amdgcn_readlane(iv, 48));
    return (r0 + r1) + (r2 + r3);
}
__device__ __forceinline__ float sum8(float v) { asm("" : "+v"(v)); v += dppf<0xB1>(v); asm("" : "+v"(v)); v += dppf<0x4E>(v); asm("" : "+v"(v)); v += dppf<0x141>(v); return v; }
__device__ __forceinline__ float siluf(float x) { return x / (1.f + __expf(-x)); }
__device__ __forceinline__ float sigmf(float x) { return 1.f / (1.f + __expf(-x)); }

struct EpiResid {
    static constexpr bool PERM = true, AFTER_DRAIN = false;
    const float* xin_l; const float* xin_c; float* xo_l; float* xo_c; const float* modl;
    __device__ __forceinline__ void operator()(const pg8::f32x4 (&acc)[2][2][4][2], const pg8::Unit& u, int wr, int wc, int fr, int fq) const {
        const int row0 = u.pm * 256 + wr * 64 + fr, col0 = u.pn * 256 + wc * 32 + 8 * fq;
#pragma unroll
        for (int ai = 0; ai < 2; ++ai)
#pragma unroll
            for (int m = 0; m < 4; ++m) {
                const int row = row0 + ai * 128 + m * 16;
                const bool lat = row < TOKL;
                const int bidx = lat ? (row >> 11) : 16;
                const float* xi = lat ? xin_l + (size_t)row * DM : xin_c + (size_t)(row - TOKL) * DM;
                float* xo = lat ? xo_l + (size_t)row * DM : xo_c + (size_t)(row - TOKL) * DM;
                const float* gp = modl + bidx * 6144 + 4096;
#pragma unroll
                for (int bj = 0; bj < 2; ++bj) {
                    const int col = col0 + bj * 128;
                    const f32x4 g0 = *(const f32x4*)(gp + col), g1 = *(const f32x4*)(gp + col + 4);
                    const f32x4 x0 = *(const f32x4*)(xi + col), x1 = *(const f32x4*)(xi + col + 4);
                    *(f32x4*)(xo + col) = x0 + g0 * acc[ai][bj][m][0];
                    *(f32x4*)(xo + col + 4) = x1 + g1 * acc[ai][bj][m][1];
                }
            }
    }
};

__device__ __forceinline__ void transpose_item(const float* W, int ld, bf16_t* dst, int K, float* scr, int lane) {
#pragma unroll 8
    for (int i = 0; i < 32; ++i) { const int kk = 2 * i + (lane >> 5); scr[kk * 33 + (lane & 31)] = W[(size_t)kk * ld + (lane & 31)]; }
    LDS_WAIT();
    const int c = lane & 7;
#pragma unroll
    for (int j = 0; j < 4; ++j) {
        const int n = (lane >> 3) + 8 * j; const float* s = scr + (8 * c) * 33 + n;
        u32x4 o; o.x = pk2(s[0], s[33]); o.y = pk2(s[2 * 33], s[3 * 33]); o.z = pk2(s[4 * 33], s[5 * 33]); o.w = pk2(s[6 * 33], s[7 * 33]);
        *(u32x4*)(dst + (size_t)n * K + 8 * c) = o;
    }
    LDS_WAIT();
}

__device__ __forceinline__ void convert_weights(const Ctx& a, const int wvs, unsigned char* lds, int l) {
    const int tid = ltid(), lane = tid & 63, wave = tid >> 6;
    unsigned char* ws = a.ws;
    float* scr = (float*)(lds + wave * 8704);
    const int gw = blockIdx.x * 8 + wave, NGW = gridDim.x * 8;
    constexpr int PER_L = 6528 + 2048 + 128;
    for (int it = gw; it < PER_L; it += NGW) {
        int r = it;
        if (r < 6528) {
            const int kb = r / 204, nb = r % 204, n0 = nb * 32, k0 = kb * 64;
            bf16_t* dst;
            if (n0 < SRC_HY) dst = (bf16_t*)(ws + WS_WTMAIN) + (size_t)n0 * DM;
            else if (n0 < SRC_GATE) dst = (bf16_t*)(ws + WS_WTHY) + (size_t)(n0 - SRC_HY) * DM;
            else dst = (bf16_t*)(ws + WS_WTMAIN) + (size_t)(n0 - SRC_GATE + C_GATE) * DM;
            transpose_item(a.in[I_WIN] + (size_t)l * DM * DIN + (size_t)k0 * DIN + n0, DIN, dst + k0, DM, scr, lane);
        } else if (r < 6528 + 2048) {
            r -= 6528; const int kb = r / 64, nb = r % 64, n0 = nb * 32, k0 = kb * 64;
            transpose_item(a.in[I_WOUT] + (size_t)l * DM * DM + (size_t)k0 * DM + n0, DM, (bf16_t*)(ws + WS_WTOUT) + (size_t)n0 * DM + k0, DM, scr, lane);
        } else {
            r -= 6528 + 2048; const int kb = r / 16, nb = r % 16, n0 = nb * 32, k0 = kb * 64;
            transpose_item(a.in[I_GLUW] + (size_t)l * 512 * 512 + (size_t)k0 * 512 + n0, 512, (bf16_t*)(ws + WS_WTGLU) + (size_t)n0 * 512 + k0, 512, scr, lane);
        }
    }
    for (int i = blockIdx.x * NTHR + tid; i < 32768; i += gridDim.x * NTHR)
        *((u32x4*)((bf16_t*)(ws + WS_WTMAIN) + (size_t)4992 * DM) + i) = (u32x4){0u, 0u, 0u, 0u};
}

__device__ __forceinline__ void phase0(const Ctx& a, const int wvs, unsigned char* lds) {
    const int tid = ltid(), lane = tid & 63, wave = tid >> 6;
    unsigned char* ws = a.ws;
    {
        float* sc = (float*)lds;
        float* part = (float*)(lds + 69632);
        float* mod = (float*)(ws + WS_MOD);
        for (int it = blockIdx.x; it < DEPTH * 96; it += gridDim.x) {
            const int l = it / 96, n0 = (it % 96) * 64;
            float acc[17];
#pragma unroll
            for (int r = 0; r < 17; ++r) acc[r] = 0.f;
            const float* W = a.in[I_WADA] + (size_t)l * DM * 6144 + n0 + lane;
            for (int kh = 0; kh < 2; ++kh) {
                __syncthreads();
                for (int i = tid; i < 17 * 1024; i += NTHR) {
                    const int r = i >> 10, k = i & 1023;
                    const float v = (r < 16) ? a.in[I_C][r * DM + kh * 1024 + k] : a.in[I_CCTX][kh * 1024 + k];
                    sc[i] = siluf(v);
                }
                __syncthreads();
                const int kb = wave * 128;
#pragma unroll 16
                for (int kk = 0; kk < 128; ++kk) {
                    const int k = kb + kk;
                    const float w = W[(size_t)(kh * 1024 + k) * 6144];
#pragma unroll
                    for (int r = 0; r < 17; ++r) acc[r] += sc[r * 1024 + k] * w;
                }
            }
#pragma unroll
            for (int r = 0; r < 17; ++r) part[(wave * 17 + r) * 64 + lane] = acc[r];
            __syncthreads();
            for (int i = tid; i < 17 * 64; i += NTHR) {
                const int r = i >> 6, cl = i & 63;
                float s = 0.f;
#pragma unroll
                for (int w = 0; w < 8; ++w) s += part[(w * 17 + r) * 64 + cl];
                mod[((size_t)l * 17 + r) * 6144 + n0 + cl] = s + a.in[I_BADA][l * 6144 + n0 + cl];
            }
        }
        __syncthreads();
    }
    {
        float* rope = (float*)(ws + WS_ROPE);
        if (blockIdx.x == 0) {
            for (int i = tid; i < 64 * 16; i += NTHR) {
                const int pos = i >> 4, ii = i & 15;
                const float inv = 1.0f / powf(10000.f, (float)ii / 16.f);
                const float ang = (float)pos * inv;
                rope[2 * i] = cosf(ang); rope[2 * i + 1] = sinf(ang);
            }
        }
        float* lbt = (float*)(ws + WS_S5LB); float* bbt = (float*)(ws + WS_S5BB);
        for (int i = blockIdx.x * NTHR + tid; i < DEPTH * 2 * 32 * 64; i += gridDim.x * NTHR) {
            const int pg = i >> 6;
            const float dt = expf(a.in[I_LSTEP][pg]);
            const float lr = a.in[I_LRE][i], li = a.in[I_LIM][i];
            const float mag = expf(lr * dt), lbr = mag * cosf(li * dt), lbi = mag * sinf(li * dt);
            const float den = lr * lr + li * li, nr = lbr - 1.f;
            const float cor = (nr * lr + lbi * li) / den, coi = (lbi * lr - nr * li) / den;
            lbt[2 * i] = lbr; lbt[2 * i + 1] = lbi;
            for (int h = 0; h < 16; ++h) {
                const float x = a.in[I_BRE][(size_t)i * 16 + h], y = a.in[I_BIM][(size_t)i * 16 + h];
                bbt[((size_t)i * 16 + h) * 2] = cor * x - coi * y; bbt[((size_t)i * 16 + h) * 2 + 1] = cor * y + coi * x;
            }
        }
    }
    {
        float* zs = (float*)lds;
        float* h1 = (float*)(lds + 4096);
        float* h2 = (float*)(lds + 8192);
        for (int it = (blockIdx.x + (gridDim.x >> 1)) % gridDim.x; it < DEPTH * 144; it += gridDim.x) {
            const int l = it / 144, r = it % 144;
            const bool isc = r >= 128; const int n = isc ? 256 : 2048; const int p0 = (isc ? r - 128 : r) * 16;
            __syncthreads();
            for (int i = tid; i < 16 * 33; i += NTHR) {
                const int pp = i / 33, e = i % 33; const int pos = p0 + pp;
                float v;
                if (e == 0) v = (float)pos / (float)(n - 1);
                else {
                    const int j = (e - 1) & 15; const float band = 1e-4f + (float)j * ((15.f - 1e-4f) / 15.f);
                    const float ang = 6.283185307179586f * (float)pos / (float)n;
                    v = (e <= 16) ? cosf(band * ang) : -sinf(band * ang);
                }
                zs[i] = v;
            }
            __syncthreads();
            for (int i = tid; i < 16 * 64; i += NTHR) {
                const int pp = i >> 6, uu = i & 63; float s = a.in[I_HB1][l * 64 + uu];
                for (int e = 0; e < 33; ++e) s += zs[pp * 33 + e] * a.in[I_HW1][(l * 33 + e) * 64 + uu];
                h1[i] = sinf(a.in[I_HF1][l * 64 + uu] * s);
            }
            __syncthreads();
            for (int i = tid; i < 16 * 64; i += NTHR) {
                const int pp = i >> 6, uu = i & 63; float s = a.in[I_HB2][l * 64 + uu];
                for (int e = 0; e < 64; ++e) s += h1[pp * 64 + e] * a.in[I_HW2][(l * 64 + e) * 64 + uu];
                h2[i] = sinf(a.in[I_HF2][l * 64 + uu] * s);
            }
            __syncthreads();
            bf16_t* G = isc ? (bf16_t*)(ws + WS_GFC) + (size_t)l * 2 * 512 * 512 : (bf16_t*)(ws + WS_GF) + (size_t)l * 2 * 512 * 4096;
            for (int q = 0; q < 4; ++q) {
                const int col = tid + NTHR * q;
                const int f = col >> 9, c = col & 511, o = f >> 1, bwd = f & 1;
                float acc[16];
#pragma unroll
                for (int pp = 0; pp < 16; ++pp) acc[pp] = 0.f;
                const float* w3 = a.in[I_HW3] + (size_t)l * 64 * 2048 + col;
                for (int e = 0; e < 64; ++e) {
                    const float w = w3[(size_t)e * 2048];
#pragma unroll
                    for (int pp = 0; pp < 16; ++pp) acc[pp] += h2[pp * 64 + e] * w;
                }
                const float lo = -3.0701134573253944f, hi = -15.350567286626972f;
                const float delta = fabsf(lo + (float)c * ((hi - lo) / 511.f));
                bf16_t* Gr = G + ((size_t)o * 512 + c) * (2 * n);
#pragma unroll
                for (int pp = 0; pp < 16; ++pp) {
                    const int pos = p0 + pp; const float t = (float)pos / (float)(n - 1);
                    float v = acc[pp] * expf(-t * delta);
                    if (!bwd) { if (pos == 0) v += a.in[I_HSKIP][(l * 2 + o) * 512 + c]; Gr[n - pos] = (bf16_t)f2bf(v); }
                    else if (pos > 0) Gr[n + pos] = (bf16_t)f2bf(v);
                    else Gr[0] = 0;
                }
            }
        }
        __syncthreads();
    }
}

__device__ __forceinline__ void norm_phase(const Ctx& a, const int wvs, int l) {
    const int tid = ltid(), lane = tid & 63, wave = tid >> 6;
    const int gw = blockIdx.x * 8 + wave, NGW = gridDim.x * 8;
    const float* xl = (l == 0) ? a.in[I_X] : a.out;
    const float* xc = (l == 0) ? a.in[I_CTX] : (const float*)(a.ws + WS_XC);
    const float* mod = (const float*)(a.ws + WS_MOD) + (size_t)l * 17 * 6144;
    const float* g = a.in[I_NORMG] + l * DM;
    bf16_t* H = (bf16_t*)(a.ws + WS_H);
    for (int row = gw; row < TOK; row += NGW) {
        const bool lat = row < TOKL;
        const float* xr = lat ? xl + (size_t)row * DM : xc + (size_t)(row - TOKL) * DM;
        const float* mr = mod + (lat ? (row >> 11) : 16) * 6144;
        f32x4 v[8]; float ss = 0.f;
#pragma unroll
        for (int j = 0; j < 8; ++j) { v[j] = *((const f32x4*)xr + lane + 64 * j); ss += (v[j].x * v[j].x + v[j].y * v[j].y) + (v[j].z * v[j].z + v[j].w * v[j].w); }
        const float rstd = 1.f / sqrtf(wave_sum(ss) * (1.f / DM) + 1e-6f);
#pragma unroll
        for (int j = 0; j < 8; ++j) {
            const int c = 4 * (lane + 64 * j);
            const f32x4 gg = *(const f32x4*)(g + c), sh = *(const f32x4*)(mr + c), sc = *(const f32x4*)(mr + 2048 + c);
            const f32x4 y = (v[j] * rstd) * gg * (sc + 1.f) + sh;
            u32x2 o; o.x = pk2(y.x, y.y); o.y = pk2(y.z, y.w);
            *(u32x2*)(H + (size_t)row * DM + c) = o;
        }
    }
}
#ifndef REP_HY_MM
#define REP_HY_MM 1
#endif
#ifndef REP_RW_CHAIN
#define REP_RW_CHAIN 1
#endif
#ifndef REP_RW_FEAT
#define REP_RW_FEAT 1
#endif
#ifndef REP_SYNC
#define REP_SYNC 1
#endif
#define GSYNC() do { for (int rs_ = 0; rs_ < REP_SYNC; ++rs_) xcd_barrier(xbar, wvs); } while (0)
#ifndef REP_ATT_STAGE
#define REP_ATT_STAGE 1
#endif
#ifndef REP_ATT_S
#define REP_ATT_S 1
#endif
#ifndef REP_RWKV
#define REP_RWKV 1
#endif
#ifndef REP_S5
#define REP_S5 1
#endif
#ifndef REP_ATT
#define REP_ATT 1
#endif
#ifndef REP_HY
#define REP_HY 1
#endif
#ifndef REP_CONV
#define REP_CONV 1
#endif
#ifndef REP_NORM
#define REP_NORM 1
#endif
#ifndef REP_MERGE
#define REP_MERGE 1
#endif
#ifndef REP_P0
#define REP_P0 1
#endif
#ifndef REP_INPROJ
#define REP_INPROJ 1
#endif
#ifndef REP_GLU
#define REP_GLU 1
#endif
#ifndef REP_HYPROJ
#define REP_HYPROJ 1
#endif
__device__ __forceinline__ float softplusf(float x) { return fmaxf(x, 0.f) + log1pf(expf(-fabsf(x))); }

typedef float f32x2 __attribute__((ext_vector_type(2)));
__device__ __forceinline__ float fsig(float x) { return __builtin_amdgcn_rcpf(1.f + __expf(-x)); }
struct RwChunk { int len, cs, rowbase; };
__device__ __forceinline__ RwChunk rw_chunk(int cc, int b) { RwChunk r; const bool isc = cc < 8; r.len = isc ? CTXL : SEQ; r.cs = isc ? cc : cc - 8; r.rowbase = isc ? TOKL + b * CTXL : b * SEQ; return r; }

__device__ __forceinline__ void rwkv_chain(const Ctx& a, const int wvs, unsigned char* lds, int l, int b, int hd, int di) {
    const int tid = ltid(), lane = tid & 63, wave = __builtin_amdgcn_readfirstlane(tid >> 6);
    float* IN = (float*)lds;
    float* YS = (float*)(lds + 98304);
    const bf16_t* proj = (const bf16_t*)(a.ws + WS_PROJ);
    __syncthreads();
    if (wave < 4) {
        f32x2 S0[4], S1[4];
#pragma unroll
        for (int j = 0; j < 4; ++j) { S0[j] = (f32x2){0.f, 0.f}; S1[j] = (f32x2){0.f, 0.f}; }
        const int i2 = tid >> 3, so = tid & 7;
#pragma unroll 1
        for (int k = 0; k < 74; ++k) {
            if (k >= 1 && k <= 72) {
                const float* INb = IN + ((k - 1) & 1) * 12288; float* YSb = YS + ((k - 1) & 1) * 2048;
#define RW_LD(tt_, P) do { const float* q_ = INb + (tt_) * 384 + 8 * so; P##ka = *(const f32x4*)(q_ + 256); P##kb = *(const f32x4*)(q_ + 260); P##wa = *(const f32x4*)(q_ + 64); P##wb = *(const f32x4*)(q_ + 68); \
                    P##ba = *(const f32x4*)(q_ + 320); P##bb = *(const f32x4*)(q_ + 324); P##da = *(const f32x4*)(q_ + 128); P##db = *(const f32x4*)(q_ + 132); P##ra = *(const f32x4*)(q_); P##rb = *(const f32x4*)(q_ + 4); \
                    P##v2 = *(const f32x2*)(INb + (tt_) * 384 + 192 + 2 * i2); } while (0)
#define RW_STEP(tt_, P) do { \
                    f32x2 t0 = S0[0] * P##ka.xy, t1 = S1[0] * P##ka.xy; \
                    t0 += S0[1] * P##ka.zw; t1 += S1[1] * P##ka.zw; t0 += S0[2] * P##kb.xy; t1 += S1[2] * P##kb.xy; t0 += S0[3] * P##kb.zw; t1 += S1[3] * P##kb.zw; \
                    const float sa0 = -sum8(t0.x + t0.y), sa1 = -sum8(t1.x + t1.y); \
                    const f32x2 s0v = {sa0, sa0}, s1v = {sa1, sa1}, v0v = {P##v2.x, P##v2.x}, v1v = {P##v2.y, P##v2.y}; \
                    S0[0] = S0[0] * P##wa.xy + (s0v * P##ba.xy + v0v * P##da.xy); S1[0] = S1[0] * P##wa.xy + (s1v * P##ba.xy + v1v * P##da.xy); \
                    S0[1] = S0[1] * P##wa.zw + (s0v * P##ba.zw + v0v * P##da.zw); S1[1] = S1[1] * P##wa.zw + (s1v * P##ba.zw + v1v * P##da.zw); \
                    S0[2] = S0[2] * P##wb.xy + (s0v * P##bb.xy + v0v * P##db.xy); S1[2] = S1[2] * P##wb.xy + (s1v * P##bb.xy + v1v * P##db.xy); \
                    S0[3] = S0[3] * P##wb.zw + (s0v * P##bb.zw + v0v * P##db.zw); S1[3] = S1[3] * P##wb.zw + (s1v * P##bb.zw + v1v * P##db.zw); \
                    f32x2 y0 = S0[0] * P##ra.xy, y1 = S1[0] * P##ra.xy; \
                    y0 += S0[1] * P##ra.zw; y1 += S1[1] * P##ra.zw; y0 += S0[2] * P##rb.xy; y1 += S1[2] * P##rb.xy; y0 += S0[3] * P##rb.zw; y1 += S1[3] * P##rb.zw; \
                    const float ys0 = sum8(y0.x + y0.y), ys1 = sum8(y1.x + y1.y); \
                    *(f32x2*)(YSb + (tt_) * 64 + 2 * i2) = (f32x2){ys0, ys1}; } while (0)
                f32x4 Aka, Akb, Awa, Awb, Aba, Abb, Ada, Adb, Ara, Arb; f32x2 Av2;
                f32x4 Bka, Bkb, Bwa, Bwb, Bba, Bbb, Bda, Bdb, Bra, Brb; f32x2 Bv2;
                f32x2 Sv0[4], Sv1[4];
#pragma unroll
                for (int j = 0; j < 4; ++j) { Sv0[j] = S0[j]; Sv1[j] = S1[j]; }
                for (int rep_ = 0; rep_ < REP_RW_CHAIN; ++rep_) {
#pragma unroll
                for (int j = 0; j < 4; ++j) { S0[j] = Sv0[j]; S1[j] = Sv1[j]; }
                RW_LD(0, A);
#pragma unroll 1
                for (int tt = 0; tt < 32; tt += 2) {
                    RW_LD(tt + 1, B);
                    RW_STEP(tt, A);
                    RW_LD((tt + 2) & 31, A);
                    RW_STEP(tt + 1, B);
                }
                }
#undef RW_LD
#undef RW_STEP
            }
            BAR_LDS();
        }
    } else {
        const int fw = wave - 4, ch = hd * 64 + lane;
        float* LWA = (float*)(lds + 114688) + fw * 512;
        bf16_t* yrw = (bf16_t*)(a.ws + WS_YRW) + (size_t)di * TOK * 512;
        float* bonus = (float*)(a.ws + WS_BONUS) + (size_t)di * TOK * 8;
        bf16_t* vmix = (bf16_t*)(a.ws + WS_VMIX);
        const float* mup = a.in[I_MUP] + l * 1664; const float* mun = a.in[I_MUN] + l * 1664;
        f32x2 w2p[16], a2p[16];
#pragma unroll
        for (int m = 0; m < 16; ++m) {
            w2p[m] = (f32x2){a.in[I_W2][(((size_t)l * 2 + di) * 32 + 2 * m) * 512 + ch], a.in[I_W2][(((size_t)l * 2 + di) * 32 + 2 * m + 1) * 512 + ch]};
            a2p[m] = (f32x2){a.in[I_A2][(((size_t)l * 2 + di) * 32 + 2 * m) * 512 + ch], a.in[I_A2][(((size_t)l * 2 + di) * 32 + 2 * m + 1) * 512 + ch]};
        }
        const float f_w0 = a.in[I_W0][(l * 2 + di) * 512 + ch], f_a0 = a.in[I_A0][(l * 2 + di) * 512 + ch];
        const float f_kk = a.in[I_KK][l * 512 + ch], f_ka = a.in[I_KA][l * 512 + ch], f_rk = a.in[I_RK][l * 512 + ch];
        const float mp_r = mup[ch], mn_r = mun[ch], mp_k = mup[512 + ch], mn_k = mun[512 + ch], mp_v = mup[1024 + ch], mn_v = mun[1024 + ch];
        const int lc = (lane < 32) ? (di * 32 + lane) : ((2 + di) * 32 + (lane - 32));
        const float mp_l = mup[1536 + lc], mn_l = mun[1536 + lc];
        unsigned short rr[10], rk[10], rv[10], rl[10];
#define RW_LOAD(cc) do { const RwChunk c_ = rw_chunk((cc), b); const int nsc0_ = c_.cs * 32 + 8 * fw; const int plo_ = di ? (c_.len - 1 - nsc0_ - 7) : nsc0_; \
        _Pragma("unroll") for (int j = 0; j < 10; ++j) { const int p_ = plo_ - 1 + j; const bool ok_ = (p_ >= 0) && (p_ < c_.len); \
            const GAS1 bf16_t* pr_ = (const GAS1 bf16_t*)proj + (size_t)(c_.rowbase + (ok_ ? p_ : 0)) * NMAIN; \
            rr[j] = ok_ ? pr_[C_RKV + ch] : (bf16_t)0; rk[j] = ok_ ? pr_[C_RKV + 512 + ch] : (bf16_t)0; rv[j] = ok_ ? pr_[C_RKV + 1024 + ch] : (bf16_t)0; rl[j] = ok_ ? pr_[C_LORA + lc] : (bf16_t)0; } } while (0)
        RW_LOAD(0);
#pragma unroll 1
        for (int k = 0; k < 74; ++k) {
            if (k >= 2) {
                const RwChunk c = rw_chunk(k - 2, b); const float* YSb = YS + ((k - 2) & 1) * 2048;
#pragma unroll
                for (int j = 0; j < 8; ++j) {
                    const int tt = 8 * fw + j, nsc = c.cs * 32 + tt, p = di ? (c.len - 1 - nsc) : nsc;
                    ((GAS1 bf16_t*)yrw)[(size_t)(c.rowbase + p) * 512 + ch] = (bf16_t)f2bf(YSb[tt * 64 + lane]);
                }
            }
            if (k <= 71) {
                const RwChunk c = rw_chunk(k, b); const int nsc0 = c.cs * 32 + 8 * fw; const int plo = di ? (c.len - 1 - nsc0 - 7) : nsc0;
                float zr[8], zk[8], zv[8];
#pragma unroll
                for (int j = 0; j < 8; ++j) {
                    const float r0 = bf2f(rr[j + 1]), k0 = bf2f(rk[j + 1]), v0 = bf2f(rv[j + 1]), l0 = bf2f(rl[j + 1]);
                    zr[j] = r0 + mp_r * (bf2f(rr[j]) - r0) + mn_r * (bf2f(rr[j + 2]) - r0);
                    zk[j] = k0 + mp_k * (bf2f(rk[j]) - k0) + mn_k * (bf2f(rk[j + 2]) - k0);
                    zv[j] = v0 + mp_v * (bf2f(rv[j]) - v0) + mn_v * (bf2f(rv[j + 2]) - v0);
                    const float zl = l0 + mp_l * (bf2f(rl[j]) - l0) + mn_l * (bf2f(rl[j + 2]) - l0);
                    const float th = 1.f - 2.f * __builtin_amdgcn_rcpf(1.f + __expf(2.f * zl));
                    LWA[j * 64 + lane] = (lane < 32) ? th : zl;
                }
                if (k + 1 <= 71) RW_LOAD(k + 1);
                LDS_WAIT();
                float* INb = IN + (k & 1) * 12288;
                for (int rep_ = 0; rep_ < REP_RW_FEAT; ++rep_)
#pragma unroll
                for (int j = 0; j < 8; ++j) {
                    const int tt = di ? (8 * fw + 7 - j) : (8 * fw + j);
                    const int row = c.rowbase + plo + j;
                    const float kkp = zk[j] * f_kk;
                    const float kk = kkp * __builtin_amdgcn_rsqf(wave_sum(kkp * kkp) + 1e-12f);
                    f32x4 lw[8], la[8];
#pragma unroll
                    for (int m4 = 0; m4 < 8; ++m4) { lw[m4] = *(const f32x4*)(LWA + j * 64 + 4 * m4); la[m4] = *(const f32x4*)(LWA + j * 64 + 32 + 4 * m4); }
                    f32x2 wa2 = {f_w0, 0.f}, aa2 = {f_a0, 0.f};
#pragma unroll
                    for (int m4 = 0; m4 < 8; ++m4) {
                        wa2 += lw[m4].xy * w2p[2 * m4]; wa2 += lw[m4].zw * w2p[2 * m4 + 1];
                        aa2 += la[m4].xy * a2p[2 * m4]; aa2 += la[m4].zw * a2p[2 * m4 + 1];
                    }
                    const float wacc = wa2.x + wa2.y, aacc = aa2.x + aa2.y;
                    const float decay = __expf(-0.6065306597126334f * fsig(wacc));
                    const float av = fsig(aacc);
                    const float kd = zk[j] * (1.f + (av - 1.f) * f_ka);
                    const float bsum = wave_sum(zr[j] * kd * f_rk);
                    if (lane == 0) ((GAS1 float*)bonus)[(size_t)row * 8 + hd] = bsum;
                    float* o = INb + tt * 384 + lane;
                    o[0] = zr[j]; o[64] = decay; o[128] = kd; o[192] = zv[j]; o[256] = kk; o[320] = kk * av;
                    if (di == 0) ((GAS1 bf16_t*)vmix)[(size_t)row * 512 + ch] = (bf16_t)f2bf(zv[j]);
                }
            }
            BAR_LDS();
        }
#undef RW_LOAD
    }
    __syncthreads();
}

__device__ __forceinline__ void unpack8(const u32x4 w, float (&v)[8]) {
    v[0] = bflo(w.x); v[1] = bfhi(w.x); v[2] = bflo(w.y); v[3] = bfhi(w.y); v[4] = bflo(w.z); v[5] = bfhi(w.z); v[6] = bflo(w.w); v[7] = bfhi(w.w);
}
__device__ __forceinline__ u32x4 pack8(const float (&v)[8]) { return (u32x4){pk2(v[0], v[1]), pk2(v[2], v[3]), pk2(v[4], v[5]), pk2(v[6], v[7])}; }
__device__ __forceinline__ float gelu_erf(float v) {
    const float av = fabsf(v), t = __builtin_amdgcn_rcpf(av * 0.2316418882f + 1.0f);
    float q = t * 0.5307027145f + (-0.7265760135f); q = q * t + 0.7107068705f; q = q * t + (-0.142248368f); q = q * t + 0.127414796f; q = q * t;
    const float e = __builtin_amdgcn_exp2f((v * v) * (-0.72134752044f));
    const float m = v * (q * e), r = v - m;
    return v < 0.f ? m : r;
}

__device__ __forceinline__ unsigned cvt_pk_bf16f(float lo, float hi) { unsigned r; asm volatile("v_cvt_pk_bf16_f32 %0, %1, %2" : "=v"(r) : "v"(lo), "v"(hi)); return r; }

__device__ __forceinline__ void s5_chain(const Ctx& a, const int wvs, unsigned char* ldsw, int l, int b, int g, int di) {
    const int lane = ltid() & 63;
    float* BU = (float*)ldsw;
    bf16_t* HB = (bf16_t*)(ldsw + 16384);
    const bf16_t* proj = (const bf16_t*)(a.ws + WS_PROJ);
    bf16_t* ys = (bf16_t*)(a.ws + (di ? WS_YSB : WS_YSF));
    const int p1 = lane & 31, hi = lane >> 5, n16 = lane & 15, q4 = lane >> 4;
    const int pg = ((l * 2 + di) * 32 + g);
    const float* lbt = (const float*)(a.ws + WS_S5LB); const float* bbt = (const float*)(a.ws + WS_S5BB);
    bf16x8 Bf[4];
#pragma unroll
    for (int nt = 0; nt < 4; ++nt) {
        const int pp = nt * 16 + (p1 >> 1), im = p1 & 1;
        const float* bp = bbt + (((size_t)pg * 64 + pp) * 16 + 8 * hi) * 2 + im;
        bf16x8 f;
#pragma unroll
        for (int jj = 0; jj < 8; ++jj) f[jj] = (short)f2bf(bp[2 * jj]);
        Bf[nt] = f;
    }
    const float ar = lbt[((size_t)pg * 64 + lane) * 2], ai = lbt[((size_t)pg * 64 + lane) * 2 + 1];
    bf16x8 Cf[4];
#pragma unroll
    for (int ks = 0; ks < 4; ++ks) {
        const int k0 = ks * 32 + 8 * q4;
        const float* cr = a.in[I_CRE] + ((size_t)pg * 16 + n16) * 64 + (k0 >> 1);
        const float* ci = a.in[I_CIM] + ((size_t)pg * 16 + n16) * 64 + (k0 >> 1);
        bf16x8 f;
#pragma unroll
        for (int jj = 0; jj < 4; ++jj) { f[2 * jj] = (short)f2bf(cr[jj]); f[2 * jj + 1] = (short)f2bf(-ci[jj]); }
        Cf[ks] = f;
    }
    float hr = 0.f, him = 0.f;
#define S5_LOADA(ci_, dst) do { const bool isc_ = (ci_) < 8; const int len_ = isc_ ? CTXL : SEQ; const int cs_ = isc_ ? (ci_) : (ci_) - 8; const int rb_ = isc_ ? TOKL + b * CTXL : b * SEQ; \
        const int nsc_ = cs_ * 32 + p1; const int p_ = di ? (len_ - 1 - nsc_) : nsc_; dst = *(const GAS1 bf16x8*)((const GAS1 bf16_t*)proj + (size_t)(rb_ + p_) * NMAIN + C_S5 + g * 16 + 8 * hi); } while (0)
    bf16x8 Anext; S5_LOADA(0, Anext);
#pragma unroll 1
    for (int ci = 0; ci < 72; ++ci) {
        const bool isc = ci < 8; const int len = isc ? CTXL : SEQ; const int cs = isc ? ci : ci - 8;
        const int rowbase = isc ? TOKL + b * CTXL : b * SEQ;
        const bf16x8 A = Anext;
        if (ci + 1 < 72) S5_LOADA(ci + 1, Anext);
#pragma unroll
        for (int nt = 0; nt < 4; ++nt) {
            f32x16 acc;
#pragma unroll
            for (int r = 0; r < 16; ++r) acc[r] = 0.f;
            acc = __builtin_amdgcn_mfma_f32_32x32x16_bf16(A, Bf[nt], acc, 0, 0, 0);
#pragma unroll
            for (int r = 0; r < 16; ++r) BU[(8 * (r >> 2) + 4 * hi + (r & 3)) * 128 + nt * 32 + p1] = acc[r];
        }
        LDS_WAIT();
#pragma unroll 1
        for (int t0 = 0; t0 < 32; t0 += 8) {
            f32x2 bu[8];
#pragma unroll
            for (int k = 0; k < 8; ++k) bu[k] = *(const f32x2*)(BU + (t0 + k) * 128 + 2 * lane);
#pragma unroll
            for (int k = 0; k < 8; ++k) {
                const float nr = ar * hr - ai * him + bu[k].x, ni = ar * him + ai * hr + bu[k].y;
                hr = nr; him = ni;
                *(unsigned*)(HB + (t0 + k) * 136 + 2 * lane) = cvt_pk_bf16f(hr, him);
            }
        }
        LDS_WAIT();
#pragma unroll
        for (int mt = 0; mt < 2; ++mt) {
            f32x4 y = {0.f, 0.f, 0.f, 0.f};
#pragma unroll
            for (int ks = 0; ks < 4; ++ks) {
                const bf16x8 Ah = *(const bf16x8*)(HB + (mt * 16 + n16) * 136 + ks * 32 + 8 * q4);
                y = __builtin_amdgcn_mfma_f32_16x16x32_bf16(Ah, Cf[ks], y, 0, 0, 0);
            }
#pragma unroll
            for (int j = 0; j < 4; ++j) {
                const int nsc = cs * 32 + mt * 16 + 4 * q4 + j; const int p = di ? (len - 1 - nsc) : nsc;
                ((GAS1 bf16_t*)ys)[(size_t)(rowbase + p) * 512 + g * 16 + n16] = (bf16_t)f2bf(y[j]);
            }
        }
        LDS_WAIT();
    }
#undef S5_LOADA
}

__device__ __forceinline__ void s5_combine(const Ctx& a, const int wvs, int l, int pr0) {
    const int tid = ltid();
    const bf16_t* proj = (const bf16_t*)(a.ws + WS_PROJ);
    const bf16_t* yf = (const bf16_t*)(a.ws + WS_YSF); const bf16_t* yb = (const bf16_t*)(a.ws + WS_YSB);
    bf16_t* ygelu = (bf16_t*)(a.ws + WS_YGELU);
#pragma unroll 3
    for (int i = tid; i < 2304 * 4; i += NTHR) {
        const int half = i & 1, pr = pr0 + ((i >> 1) & 1), tok = i >> 2;
        const int b = pr >> 5, g = pr & 31;
        const int row = tok < CTXL ? TOKL + b * CTXL + tok : b * SEQ + (tok - CTXL);
        const size_t idx = (size_t)row * 512 + g * 16 + 8 * half;
        const u32x4 fw = *(const u32x4*)(yf + idx), bw = *(const u32x4*)(yb + idx);
        const u32x4 uw = *(const u32x4*)(proj + (size_t)row * NMAIN + C_S5 + g * 16 + 8 * half);
        const float* dk = a.in[I_S5D] + (l * 32 + g) * 16 + 8 * half;
        float v[8], vb[8]; unpack8(fw, v); unpack8(bw, vb);
#pragma unroll
        for (int e = 0; e < 8; ++e) v[e] += vb[e];
        float u[8]; unpack8(uw, u);
#pragma unroll
        for (int e = 0; e < 8; ++e) v[e] = gelu_erf(v[e] + dk[e] * u[e]);
        *(u32x4*)(ygelu + idx) = pack8(v);
    }
}

__device__ __forceinline__ void attn_unit(const Ctx& a, const int wvs, unsigned char* lds, int l, int b, int hp, int qb, bool qctx) {
    const int tid = ltid(), lane = tid & 63, wave = tid >> 6, n16 = lane & 15, q4 = lane >> 4;
    bf16_t* Ks = (bf16_t*)lds;
    bf16_t* Vt = (bf16_t*)(lds + 18432);
    const bf16_t* proj = (const bf16_t*)(a.ws + WS_PROJ);
    bf16_t* yatt = (bf16_t*)(a.ws + WS_YATT);
    const float* qg = a.in[I_QG] + l * 64; const float* kg = a.in[I_KG] + l * 64;
    const float* rope = (const float*)(a.ws + WS_ROPE);
    const int kvh = hp >> 1;
    const float LOG2E = 1.4426950408889634f;
    const int qi = wave * 16 + n16;
    const int qpos = qb * 128 + qi;
    const int qrow = qctx ? TOKL + b * CTXL + qpos : b * SEQ + qpos;
#define ATT_VALID(t) (((t) >= 3) || (!qctx && (qb - 1 + (t)) >= 0 && (qb - 1 + (t)) <= 15))
#define ATT_KROW0(t) (((t) < 3) ? b * SEQ + (qb - 1 + (t)) * 128 : TOKL + b * CTXL + ((t) - 3) * 128)
    u32x2 kra[2], krb[2]; u32x4 vr[2];
#define ATT_LOAD(t) do { const int kr0_ = ATT_KROW0(t); _Pragma("unroll") for (int i = 0; i < 2; ++i) { const int tk = tid + NTHR * i; const int key = tk >> 3, sub = tk & 7, hf = sub >> 2, aa = sub & 3; \
        const GAS1 bf16_t* kp = (const GAS1 bf16_t*)proj + (size_t)(kr0_ + key) * NMAIN + C_K + kvh * 64 + hf * 32 + 4 * aa; kra[i] = *(const GAS1 u32x2*)kp; krb[i] = *(const GAS1 u32x2*)(kp + 16); \
        vr[i] = *(const GAS1 u32x4*)((const GAS1 bf16_t*)proj + (size_t)(kr0_ + key) * NMAIN + C_V + kvh * 64 + 8 * sub); } } while (0)
    int t = 0;
    while (!ATT_VALID(t)) ++t;
    ATT_LOAD(t);
    bf16x8 Qf[2][2];
    float m[2], lsum[2];
    f32x4 o[2][4];
#pragma unroll
    for (int h2 = 0; h2 < 2; ++h2) {
        const int hq = 2 * hp + h2;
        float va[2][4], vb[2][4]; float ss = 0.f;
#pragma unroll
        for (int hf = 0; hf < 2; ++hf) {
            const bf16_t* qp = proj + (size_t)qrow * NMAIN + C_Q + hq * 64 + hf * 32 + 4 * q4;
            const u32x2 wa = *(const u32x2*)qp, wb = *(const u32x2*)(qp + 16);
            va[hf][0] = bflo(wa.x); va[hf][1] = bfhi(wa.x); va[hf][2] = bflo(wa.y); va[hf][3] = bfhi(wa.y);
            vb[hf][0] = bflo(wb.x); vb[hf][1] = bfhi(wb.x); vb[hf][2] = bflo(wb.y); vb[hf][3] = bfhi(wb.y);
#pragma unroll
            for (int jj = 0; jj < 4; ++jj) ss += va[hf][jj] * va[hf][jj] + vb[hf][jj] * vb[hf][jj];
        }
        ss += __shfl_xor(ss, 16); ss += __shfl_xor(ss, 32);
        const float rstd = __builtin_amdgcn_rsqf(ss * (1.f / 64.f) + 1e-6f);
        const float qs = 0.125f * LOG2E;
#pragma unroll
        for (int hf = 0; hf < 2; ++hf) {
            const int ipos = (hf == 0 ? (qpos >> 6) : (qpos & 63));
            bf16x8 f;
#pragma unroll
            for (int jj = 0; jj < 4; ++jj) {
                const int i = 4 * q4 + jj;
                float u1 = va[hf][jj] * rstd * qg[hf * 32 + i], u2 = vb[hf][jj] * rstd * qg[hf * 32 + 16 + i];
                if (!qctx) {
                    const f32x2 csn = *(const GAS1 f32x2*)((const GAS1 float*)rope + (ipos * 16 + i) * 2);
                    const float o1 = u1 * csn.x - u2 * csn.y, o2 = u2 * csn.x + u1 * csn.y; u1 = o1; u2 = o2;
                }
                f[jj] = (short)f2bf(u1 * qs); f[4 + jj] = (short)f2bf(u2 * qs);
            }
            Qf[h2][hf] = f;
        }
        m[h2] = a.in[I_SINK][l * 8 + hq] * LOG2E; lsum[h2] = (q4 == 0) ? 1.f : 0.f;
#pragma unroll
        for (int i = 0; i < 4; ++i) o[h2][i] = (f32x4){0.f, 0.f, 0.f, 0.f};
    }
    const int vsw0 = ((n16 >> 3) & 1);
#pragma unroll 1
    while (t < 5) {
        int tn = t + 1;
        while (tn < 5 && !ATT_VALID(tn)) ++tn;
        const bool local = t < 3; const int kb = local ? qb - 1 + t : 0;
        BAR_LDS();
#pragma unroll
        for (int i = 0; i < 2; ++i) {
            const int tk = tid + NTHR * i; const int key = tk >> 3, sub = tk & 7, hf = sub >> 2, aa = sub & 3;
            const u32x2 wa = kra[i], wb = krb[i];
            float ua[4] = {bflo(wa.x), bfhi(wa.x), bflo(wa.y), bfhi(wa.y)}, ub[4] = {bflo(wb.x), bfhi(wb.x), bflo(wb.y), bfhi(wb.y)};
            float ss = 0.f;
#pragma unroll
            for (int jj = 0; jj < 4; ++jj) ss += ua[jj] * ua[jj] + ub[jj] * ub[jj];
            ss = sum8(ss);
            const float rstd = __builtin_amdgcn_rsqf(ss * (1.f / 64.f) + 1e-6f);
            const int kpos = kb * 128 + key;
            const int ipos = (hf == 0 ? (kpos >> 6) : (kpos & 63)) & 63;
            unsigned w[4];
            float oa[4], ob[4];
#pragma unroll
            for (int jj = 0; jj < 4; ++jj) {
                const int ii = 4 * aa + jj;
                float u1 = ua[jj] * rstd * ((const GAS1 float*)kg)[hf * 32 + ii], u2 = ub[jj] * rstd * ((const GAS1 float*)kg)[hf * 32 + 16 + ii];
                if (local) {
                    const f32x2 csn = *(const GAS1 f32x2*)((const GAS1 float*)rope + (ipos * 16 + ii) * 2);
                    const float o1 = u1 * csn.x - u2 * csn.y, o2 = u2 * csn.x + u1 * csn.y; u1 = o1; u2 = o2;
                }
                oa[jj] = u1; ob[jj] = u2;
            }
            w[0] = pk2(oa[0], oa[1]); w[1] = pk2(oa[2], oa[3]); w[2] = pk2(ob[0], ob[1]); w[3] = pk2(ob[2], ob[3]);
            *(u32x4*)(Ks + key * 72 + hf * 32 + 8 * aa) = (u32x4){w[0], w[1], w[2], w[3]};
            const u32x4 vv = vr[i];
            bf16_t* vt = Vt + (8 * sub) * 136 + (key ^ (sub << 3));
            vt[0] = (bf16_t)(vv.x & 0xffff); vt[136] = (bf16_t)(vv.x >> 16); vt[2 * 136] = (bf16_t)(vv.y & 0xffff); vt[3 * 136] = (bf16_t)(vv.y >> 16);
            vt[4 * 136] = (bf16_t)(vv.z & 0xffff); vt[5 * 136] = (bf16_t)(vv.z >> 16); vt[6 * 136] = (bf16_t)(vv.w & 0xffff); vt[7 * 136] = (bf16_t)(vv.w >> 16);
        }
        if (tn < 5) ATT_LOAD(tn);
        BAR_LDS();
        f32x4 s[2][8];
        const int dlo = (local && kb == qb - 1) ? wvs : 0;
        const int dhi = (local && kb == qb + 1) ? wvs : 7;
#pragma unroll
        for (int mt = 0; mt < 8; ++mt) {
            if (mt < dlo || mt > dhi) { s[0][mt] = (f32x4){-1e30f, -1e30f, -1e30f, -1e30f}; s[1][mt] = s[0][mt]; }
            else {
            s[0][mt] = (f32x4){0.f, 0.f, 0.f, 0.f}; s[1][mt] = (f32x4){0.f, 0.f, 0.f, 0.f};
#pragma unroll
            for (int hf = 0; hf < 2; ++hf) {
                const bf16x8 A = *(const bf16x8*)(Ks + (mt * 16 + n16) * 72 + hf * 32 + 8 * q4);
                s[0][mt] = __builtin_amdgcn_mfma_f32_16x16x32_bf16(A, Qf[0][hf], s[0][mt], 0, 0, 0);
                s[1][mt] = __builtin_amdgcn_mfma_f32_16x16x32_bf16(A, Qf[1][hf], s[1][mt], 0, 0, 0);
            }
            }
        }
        if (local && kb != qb) {
#pragma unroll
            for (int mt = 0; mt < 8; ++mt)
#pragma unroll
                for (int j = 0; j < 4; ++j) {
                    const int kpos = kb * 128 + mt * 16 + 4 * q4 + j; int df = qpos - kpos; df = df < 0 ? -df : df;
                    if (df > 128) { s[0][mt][j] = -1e30f; s[1][mt][j] = -1e30f; }
                }
        }
#pragma unroll
        for (int h2 = 0; h2 < 2; ++h2) {
            float mx = -3e38f;
#pragma unroll
            for (int mt = 0; mt < 8; ++mt) mx = fmaxf(fmaxf(fmaxf(s[h2][mt][0], s[h2][mt][1]), fmaxf(s[h2][mt][2], s[h2][mt][3])), mx);
            mx = fmaxf(mx, __shfl_xor(mx, 16)); mx = fmaxf(mx, __shfl_xor(mx, 32));
            const float mn = fmaxf(m[h2], mx), alpha = __builtin_amdgcn_exp2f(m[h2] - mn); m[h2] = mn;
            float ps = 0.f;
#pragma unroll
            for (int mt = 0; mt < 8; ++mt) {
                if (mt < dlo || mt > dhi) s[h2][mt] = (f32x4){0.f, 0.f, 0.f, 0.f};
                else {
#pragma unroll
                for (int j = 0; j < 4; ++j) { const float p = __builtin_amdgcn_exp2f(s[h2][mt][j] - mn); s[h2][mt][j] = p; ps += p; }
                }
            }
            lsum[h2] = lsum[h2] * alpha + ps;
#pragma unroll
            for (int i = 0; i < 4; ++i) o[h2][i] = o[h2][i] * alpha;
        }
#pragma unroll
        for (int ks = 0; ks < 4; ++ks) {
            if (2 * ks + 1 < dlo || 2 * ks > dhi) continue;
            bf16x8 Bp[2];
#pragma unroll
            for (int h2 = 0; h2 < 2; ++h2) {
                u32x4 bp;
                bp.x = cvt_pk_bf16f(s[h2][2 * ks][0], s[h2][2 * ks][1]); bp.y = cvt_pk_bf16f(s[h2][2 * ks][2], s[h2][2 * ks][3]);
                bp.z = cvt_pk_bf16f(s[h2][2 * ks + 1][0], s[h2][2 * ks + 1][1]); bp.w = cvt_pk_bf16f(s[h2][2 * ks + 1][2], s[h2][2 * ks + 1][3]);
                Bp[h2] = __builtin_bit_cast(bf16x8, bp);
            }
#pragma unroll
            for (int md = 0; md < 4; ++md) {
                const int sw = ((2 * md + vsw0) & 7) << 3;
                const bf16_t* vrow = Vt + (md * 16 + n16) * 136;
                const u32x2 v0 = *(const u32x2*)(vrow + ((ks * 32 + 4 * q4) ^ sw)), v1 = *(const u32x2*)(vrow + ((ks * 32 + 16 + 4 * q4) ^ sw));
                const bf16x8 av = __builtin_bit_cast(bf16x8, (u32x4){v0.x, v0.y, v1.x, v1.y});
                o[0][md] = __builtin_amdgcn_mfma_f32_16x16x32_bf16(av, Bp[0], o[0][md], 0, 0, 0);
                o[1][md] = __builtin_amdgcn_mfma_f32_16x16x32_bf16(av, Bp[1], o[1][md], 0, 0, 0);
            }
        }
        t = tn;
    }
#undef ATT_VALID
#undef ATT_KROW0
#undef ATT_LOAD
#pragma unroll
    for (int h2 = 0; h2 < 2; ++h2) {
        float ls = lsum[h2];
        ls += __shfl_xor(ls, 16); ls += __shfl_xor(ls, 32);
        const float il = __builtin_amdgcn_rcpf(ls);
#pragma unroll
        for (int md = 0; md < 4; ++md) {
            u32x2 w; w.x = pk2(o[h2][md][0] * il, o[h2][md][1] * il); w.y = pk2(o[h2][md][2] * il, o[h2][md][3] * il);
            *(u32x2*)(yatt + (size_t)qrow * 512 + (2 * hp + h2) * 64 + md * 16 + 4 * q4) = w;
        }
    }
}

__device__ __forceinline__ unsigned fsr16(unsigned lo, unsigned hi) { return __builtin_amdgcn_alignbit(hi, lo, 16); }

__device__ __forceinline__ void hyena_item(const Ctx& a, const int wvs, unsigned char* lds, int l, int c, bool isc) {
    const int tid = ltid(), lane = tid & 63, wave = tid >> 6, n16 = lane & 15, q4 = lane >> 4;
    const int n = isc ? CTXL : SEQ, tokbase = isc ? TOKL : 0, UST = n + 8, GST = 2 * n + 16;
    bf16_t* Ub = (bf16_t*)lds;
    bf16_t* Gs = (bf16_t*)(lds + 16 * UST * 2);
    const bf16_t* hyT = (const bf16_t*)(a.ws + WS_HYT);
    bf16_t* yh = (bf16_t*)(a.ws + WS_YHYT);
    const float* cw = a.in[I_HCW] + (size_t)l * 3 * 1536; const float* cb = a.in[I_HCB] + (size_t)l * 1536;
    u32x2 yst0[8], yst1[8];
#pragma unroll
    for (int r = 0; r < 8; ++r) { yst0[r] = (u32x2){0u, 0u}; yst1[r] = (u32x2){0u, 0u}; }
#pragma unroll 1
    for (int o = 0; o < 2; ++o) {
        BAR_LDS();
        const int n8 = n >> 3;
        u32x4 g0pre;
        {
            const bf16_t* Gp = isc ? (const bf16_t*)(a.ws + WS_GFC) + (((size_t)l * 2 + o) * 512 + c) * 512 : (const bf16_t*)(a.ws + WS_GF) + (((size_t)l * 2 + o) * 512 + c) * 4096;
            g0pre = (tid < 2 * n8) ? *(const u32x4*)(Gp + 8 * tid) : (u32x4){0u, 0u, 0u, 0u};
        }
        if (o == 0) {
            const bf16_t* src = hyT + (size_t)c * TOK + tokbase;
            const float w0 = cw[c], w1 = cw[1536 + c], w2 = cw[3072 + c], bs = cb[c];
#pragma unroll 8
            for (int i = tid; i < 16 * n8; i += NTHR) {
                const int bb = i / n8, t8 = (i - bb * n8) * 8;
                const bf16_t* s = src + bb * n + t8;
                float v[10]; float e[8];
                unpack8(*(const u32x4*)s, e);
                v[0] = t8 > 0 ? bf2f(s[-1]) : 0.f; v[9] = (t8 + 8 < n) ? bf2f(s[8]) : 0.f;
#pragma unroll
                for (int k = 0; k < 8; ++k) v[k + 1] = e[k];
                float r[8];
#pragma unroll
                for (int k = 0; k < 8; ++k) r[k] = w0 * v[k] + w1 * v[k + 1] + w2 * v[k + 2] + bs;
                *(u32x4*)(Ub + bb * UST + t8) = pack8(r);
            }
        } else {
#pragma unroll 1
            for (int gi = 0; gi < 2; ++gi) {
                const int grp = wave + 8 * gi;
                if (grp < (n >> 7)) {
#pragma unroll
                    for (int r = 0; r < 8; ++r) *(u32x2*)(Ub + n16 * UST + 16 * (grp * 8 + r) + 4 * q4) = (gi == 0) ? yst0[r] : yst1[r];
                }
            }
        }
        {
            const bf16_t* G = isc ? (const bf16_t*)(a.ws + WS_GFC) + (((size_t)l * 2 + o) * 512 + c) * 512 : (const bf16_t*)(a.ws + WS_GF) + (((size_t)l * 2 + o) * 512 + c) * 4096;
            const int nch = GST >> 3;
            *(u32x4*)(Gs + 8 * tid) = g0pre;
            for (int m = tid + NTHR; m < nch; m += NTHR) *(u32x4*)(Gs + 8 * m) = (m < 2 * n8) ? *(const u32x4*)(G + 8 * m) : (u32x4){0u, 0u, 0u, 0u};
            BAR_LDS();
            for (int m = tid; m < nch; m += NTHR) {
                const u32x4 hi4 = *(const u32x4*)(Gs + 8 * m);
                const u32x4 lo4 = (m > 0) ? *(const u32x4*)(Gs + 8 * m - 8) : (u32x4){0u, 0u, 0u, 0u};
                const unsigned d[8] = {lo4.x, lo4.y, lo4.z, lo4.w, hi4.x, hi4.y, hi4.z, hi4.w};
#pragma unroll
                for (int k = 1; k < 8; ++k) {
                    u32x4 w;
                    if ((k & 1) == 0) { w.x = d[4 - k / 2]; w.y = d[5 - k / 2]; w.z = d[6 - k / 2]; w.w = d[7 - k / 2]; }
                    else { const int s = (8 - k) >> 1; w.x = fsr16(d[s], d[s + 1]); w.y = fsr16(d[s + 1], d[s + 2]); w.z = fsr16(d[s + 2], d[s + 3]); w.w = (s + 4 < 8) ? fsr16(d[s + 3], d[s + 4]) : 0u; }
                    *(u32x4*)(Gs + k * GST + 8 * m) = w;
                }
            }
        }
        BAR_LDS();
        const int xch = 512 * (o + 1) + c;
        const float xw0 = cw[xch], xw1 = cw[1536 + xch], xw2 = cw[3072 + xch], xbs = cb[xch];
        const bf16_t* xsrc = hyT + (size_t)xch * TOK + tokbase + n16 * n;
        bf16_t* dst = yh + (size_t)c * TOK + tokbase + n16 * n;
        const bf16_t* gl = Gs + (n16 & 7) * GST + n + 8 * q4 - 8 * (n16 >> 3);
        const bf16_t* bbp = Ub + n16 * UST + 8 * q4;
#pragma unroll 1
        for (int gi = 0; gi < 2; ++gi) {
            const int grp = wave + 8 * gi;
            if (grp < (n >> 7)) {
            const int tau0 = grp * 8;
            bf16x8 Af[8]; f32x4 acc[8];
#pragma unroll
            for (int r = 0; r < 8; ++r) acc[r] = (f32x4){0.f, 0.f, 0.f, 0.f};
#pragma unroll
            for (int r = 2; r < 8; ++r) Af[r] = *(const bf16x8*)(gl - 16 * (tau0 + r));
            u32x2 xm[8]; bf16_t xl[8], xr[8];
#pragma unroll
            for (int r = 0; r < 8; ++r) {
                const int tb = 16 * (tau0 + r) + 4 * q4;
                xm[r] = *(const GAS1 u32x2*)((const GAS1 bf16_t*)xsrc + tb);
                xl[r] = (tb > 0) ? ((const GAS1 bf16_t*)xsrc)[tb - 1] : (bf16_t)0;
                xr[r] = (tb + 4 < n) ? ((const GAS1 bf16_t*)xsrc)[tb + 4] : (bf16_t)0;
            }
#pragma unroll 2
            for (int s4 = 0; s4 < (n >> 5); s4 += 4) {
#pragma unroll
                for (int u = 0; u < 4; ++u) {
                    const int sg = s4 + u;
                    Af[(8 - 2 * u) & 7] = *(const bf16x8*)(gl - 16 * (tau0 - 2 * sg));
                    Af[(9 - 2 * u) & 7] = *(const bf16x8*)(gl - 16 * (tau0 - 2 * sg + 1));
                    const bf16x8 B = *(const bf16x8*)(bbp + 32 * sg);
#pragma unroll
                    for (int r = 0; r < 8; ++r) acc[r] = __builtin_amdgcn_mfma_f32_16x16x32_bf16(Af[(r - 2 * u + 8) & 7], B, acc[r], 0, 0, 0);
                }
            }
#pragma unroll
            for (int r = 0; r < 8; ++r) {
                const int tb = 16 * (tau0 + r) + 4 * q4;
                const float xv[6] = {bf2f(xl[r]), bflo(xm[r].x), bfhi(xm[r].x), bflo(xm[r].y), bfhi(xm[r].y), bf2f(xr[r])};
                float rr[4];
#pragma unroll
                for (int j = 0; j < 4; ++j) rr[j] = (xw0 * xv[j] + xw1 * xv[j + 1] + xw2 * xv[j + 2] + xbs) * acc[r][j];
                u32x2 w; w.x = pk2(rr[0], rr[1]); w.y = pk2(rr[2], rr[3]);
                if (o == 0) { yst0[r] = (gi == 0) ? w : yst0[r]; yst1[r] = (gi == 1) ? w : yst1[r]; } else *(GAS1 u32x2*)((GAS1 bf16_t*)dst + tb) = w;
            }
            }
        }
    }
    BAR_LDS();
}


__device__ __forceinline__ void merge_phase(const Ctx& a, const int wvs, unsigned char* lds, int l) {
    const int tid = ltid(), lane = tid & 63, wave = tid >> 6;
    bf16_t* HyS = (bf16_t*)lds;
    const bf16_t* proj = (const bf16_t*)(a.ws + WS_PROJ);
    const bf16_t* ygelu = (const bf16_t*)(a.ws + WS_YGELU); const bf16_t* zglu = (const bf16_t*)(a.ws + WS_ZGLU);
    const bf16_t* yatt = (const bf16_t*)(a.ws + WS_YATT); const bf16_t* yrw = (const bf16_t*)(a.ws + WS_YRW);
    const float* bonus = (const float*)(a.ws + WS_BONUS); const bf16_t* vmix = (const bf16_t*)(a.ws + WS_VMIX);
    const bf16_t* yh = (const bf16_t*)(a.ws + WS_YHYT);
    bf16_t* ymix = (bf16_t*)(a.ws + WS_YMIX);
    const int TR = (l < DEPTH - 1) ? 48 : 64, RW = TR >> 3;
    const int ntile = (l < DEPTH - 1 ? TOK : TOKL) / TR;
    const int c0 = 8 * lane;
    float bg0[8], bg1[8], bg2[8], glb[8], lng[8], lnb[8];
#pragma unroll
    for (int e = 0; e < 8; ++e) {
        bg0[e] = a.in[I_BRG][(l * 3 + 0) * 512 + c0 + e]; bg1[e] = a.in[I_BRG][(l * 3 + 1) * 512 + c0 + e]; bg2[e] = a.in[I_BRG][(l * 3 + 2) * 512 + c0 + e];
        glb[e] = a.in[I_GLUB][l * 512 + c0 + e]; lng[e] = a.in[I_LNG][l * 512 + c0 + e]; lnb[e] = a.in[I_LNB][l * 512 + c0 + e];
    }
#pragma unroll 1
    for (int tile = blockIdx.x; tile < ntile; tile += gridDim.x) {
        const int row0 = tile * TR;
        BAR_LDS();
#pragma unroll
        for (int i = 0; i < 8; ++i) {
            const int tk = tid + NTHR * i; const int c = tk >> 3, rg = tk & 7;
            if (rg >= RW) continue;
            const u32x4 w = *(const u32x4*)(yh + (size_t)c * TOK + row0 + 8 * rg);
            bf16_t* d = HyS + (8 * rg) * 520 + c;
            d[0] = (bf16_t)(w.x & 0xffff); d[520] = (bf16_t)(w.x >> 16); d[2 * 520] = (bf16_t)(w.y & 0xffff); d[3 * 520] = (bf16_t)(w.y >> 16);
            d[4 * 520] = (bf16_t)(w.z & 0xffff); d[5 * 520] = (bf16_t)(w.z >> 16); d[6 * 520] = (bf16_t)(w.w & 0xffff); d[7 * 520] = (bf16_t)(w.w >> 16);
        }
        BAR_LDS();
#pragma unroll 2
        for (int rr = 0; rr < RW; ++rr) {
            const int rl = wave * RW + rr; const size_t row = (size_t)row0 + rl;
            const bf16_t* gp = proj + row * NMAIN + C_GATE + c0;
            const u32x4 L_g0 = *(const u32x4*)gp, L_g1 = *(const u32x4*)(gp + 512), L_g2 = *(const u32x4*)(gp + 1024), L_g3 = *(const u32x4*)(gp + 1536);
            const u32x4 L_yg = *(const u32x4*)(ygelu + row * 512 + c0), L_z = *(const u32x4*)(zglu + row * 512 + c0), L_ya = *(const u32x4*)(yatt + row * 512 + c0);
            const u32x4 L_r0 = *(const u32x4*)(yrw + row * 512 + c0), L_r1 = *(const u32x4*)(yrw + (size_t)TOK * 512 + row * 512 + c0), L_vm = *(const u32x4*)(vmix + row * 512 + c0);
            const int hd = lane >> 3;
            const float bon = bonus[row * 8 + hd] + bonus[(size_t)TOK * 8 + row * 8 + hd];
            const u32x4 L_hy = *(const u32x4*)(HyS + rl * 520 + c0);
            float v[8], g[8], z[8], o0[8], o1[8], o2[8];
            unpack8(L_yg, v); unpack8(L_z, z); unpack8(L_g0, g);
            float ss = 0.f;
#pragma unroll
            for (int e = 0; e < 8; ++e) { v[e] = v[e] * sigmf(z[e] + glb[e]); ss += v[e] * v[e]; }
            float rstd = __builtin_amdgcn_rsqf(wave_sum(ss) * (1.f / 512.f) + 1e-6f);
#pragma unroll
            for (int e = 0; e < 8; ++e) o0[e] = v[e] * rstd * bg0[e] * siluf(g[e]);
            unpack8(L_ya, v); unpack8(L_g1, g);
            ss = 0.f;
#pragma unroll
            for (int e = 0; e < 8; ++e) ss += v[e] * v[e];
            rstd = __builtin_amdgcn_rsqf(wave_sum(ss) * (1.f / 512.f) + 1e-6f);
#pragma unroll
            for (int e = 0; e < 8; ++e) o1[e] = v[e] * rstd * bg1[e] * siluf(g[e]);
            unpack8(L_r0, v); unpack8(L_r1, z); unpack8(L_g2, g);
            float sm = 0.f;
#pragma unroll
            for (int e = 0; e < 8; ++e) { v[e] += z[e]; sm += v[e]; }
            const float mu = sum8(sm) * (1.f / 64.f);
            float sv = 0.f;
#pragma unroll
            for (int e = 0; e < 8; ++e) { v[e] -= mu; sv += v[e] * v[e]; }
            const float rs = __builtin_amdgcn_rsqf(sum8(sv) * (1.f / 64.f) + 64e-5f);
            unpack8(L_vm, z);
#pragma unroll
            for (int e = 0; e < 8; ++e) o2[e] = (v[e] * rs * lng[e] + lnb[e] + bon * z[e]) * siluf(g[e]);
            unpack8(L_hy, v); unpack8(L_g3, g);
            ss = 0.f;
#pragma unroll
            for (int e = 0; e < 8; ++e) ss += v[e] * v[e];
            rstd = __builtin_amdgcn_rsqf(wave_sum(ss) * (1.f / 512.f) + 1e-6f);
#pragma unroll
            for (int e = 0; e < 8; ++e) v[e] = v[e] * rstd * bg2[e] * siluf(g[e]);
            *(u32x4*)(ymix + row * DM + c0) = pack8(o0);
            *(u32x4*)(ymix + row * DM + 512 + c0) = pack8(o1);
            *(u32x4*)(ymix + row * DM + 1024 + c0) = pack8(o2);
            *(u32x4*)(ymix + row * DM + 1536 + c0) = pack8(v);
        }
    }
    __syncthreads();
}

#define LAS __attribute__((address_space(3)))
#define XB_TMO      128
#define XB_XCNT(j)  (256  + 64 * (j))
#define XB_XSUB(j)  (1280 + 64 * (j))
#define XB_XGEN(j)  (2304 + 64 * (j))
#define XB_TOP      3328
#define XB_TOPGEN   3392
#define XCD_BAR_WORDS 3456
#define XB_SPIN_CAP (1u << 22)

__device__ __forceinline__ unsigned xb_ld(unsigned* p)              { return __hip_atomic_load(p, __ATOMIC_RELAXED, __HIP_MEMORY_SCOPE_AGENT); }
__device__ __forceinline__ unsigned xb_add(unsigned* p, unsigned v) { return __hip_atomic_fetch_add(p, v, __ATOMIC_RELAXED, __HIP_MEMORY_SCOPE_AGENT); }
__device__ __forceinline__ unsigned xb_xcc_id() { return (unsigned)__builtin_amdgcn_s_getreg((3 << 11) | 20) & 0xFu; }
#define XB_SPIN(cond, bar) do { unsigned _sp = 0; while (cond) { __builtin_amdgcn_s_sleep(1); \
    if ((++_sp & 255u) == 0u) { if (xb_ld(&(bar)[XB_TMO])) break; if (_sp > XB_SPIN_CAP) { atomicAdd(&(bar)[XB_TMO], 1u); break; } } } } while (0)

struct XcdBarrier {
    unsigned* bar; unsigned x;
    volatile LAS unsigned* st;
};

__device__ __forceinline__ XcdBarrier xcd_barrier_post(unsigned* bar, volatile LAS unsigned* st, const int wvs) {
    XcdBarrier b; b.bar = bar; b.x = xb_xcc_id(); b.st = st;
    if (ltid() == 0) (void)xb_add(&bar[XB_XCNT(b.x)], 1u);
    return b;
}
__device__ __forceinline__ void xcd_barrier_complete(unsigned* bar, unsigned x, unsigned& nloc, unsigned& nx) {
    const unsigned G = gridDim.x * gridDim.y * gridDim.z;
    unsigned sum, cnt, mine, sp = 0u;
    for (;;) {
        sum = 0u; cnt = 0u; mine = 0u;
#pragma unroll
        for (unsigned j = 0; j < 16; ++j) { const unsigned c = xb_ld(&bar[XB_XCNT(j)]); sum += c; cnt += (c > 0u) ? 1u : 0u; mine = (j == x) ? c : mine; }
        if (sum == G) break;
        __builtin_amdgcn_s_sleep(1);
        if ((++sp & 255u) == 0u) { if (xb_ld(&bar[XB_TMO])) break; if (sp > XB_SPIN_CAP) { atomicAdd(&bar[XB_TMO], 1u); break; } }
    }
    nloc = mine > 0u ? mine : 1u; nx = cnt > 0u ? cnt : 1u;
}

__device__ __forceinline__ void xcd_barrier(const XcdBarrier& b, const int wvs) {
    asm volatile("s_waitcnt vmcnt(0)" ::: "memory");
    __syncthreads();
    if (ltid() == 0) {
        unsigned* bar = b.bar;
        __builtin_amdgcn_s_waitcnt(0);
        unsigned nloc = b.st[0], nx = b.st[1];
        if (nloc == 0u) { xcd_barrier_complete(bar, b.x, nloc, nx); b.st[0] = nloc; b.st[1] = nx; }
        const unsigned old = xb_add(&bar[XB_XSUB(b.x)], 1u);
        const unsigned gen = old / nloc;
        if (old + 1u == (gen + 1u) * nloc) {
            __builtin_amdgcn_fence(__ATOMIC_RELEASE, "agent");
            asm volatile("s_waitcnt vmcnt(0)" ::: "memory");
            const unsigned og = xb_add(&bar[XB_TOP], 1u);
            const unsigned tg = og / nx;
            if (og + 1u == (tg + 1u) * nx) xb_add(&bar[XB_TOPGEN], 1u);
            else XB_SPIN(xb_ld(&bar[XB_TOPGEN]) == tg, bar);
            __builtin_amdgcn_fence(__ATOMIC_ACQUIRE, "agent");
            xb_add(&bar[XB_XGEN(b.x)], 1u);
            asm volatile("s_waitcnt vmcnt(0)" ::: "memory");
        } else {
            XB_SPIN(xb_ld(&bar[XB_XGEN(b.x)]) == gen, bar);
            __builtin_amdgcn_fence(__ATOMIC_ACQUIRE, "agent");
            asm volatile("s_waitcnt vmcnt(0)" ::: "memory");
        }
    }
    __syncthreads();
}


__device__ __forceinline__ unsigned char* launder(unsigned char* p) { GAS1 unsigned char* q = (GAS1 unsigned char*)p; asm volatile("" : "+s"(q)); return (unsigned char*)q; }
#define MKCTX() Ctx a; { unsigned char* w_ = as_global(launder(ka.ws)); a.ws = w_; a.in.t = (const float* const*)(w_ + WS_TAB); a.out = (float*)(a.in[N_IN]); }
__global__ void __launch_bounds__(NTHR, 2) fwd_mega(Args ka) {
    extern __shared__ __attribute__((aligned(16))) unsigned char lds[];
    const int wvs = __builtin_amdgcn_readfirstlane((int)threadIdx.x >> 6);
    const int tid = ltid();
    const int G = gridDim.x, bid = blockIdx.x;
    PG8_LAS unsigned char* glds = (PG8_LAS unsigned char*)lds;
    if (tid == 0) {
        const float** tab = (const float**)(launder(ka.ws) + WS_TAB);
#define TW(i) tab[i] = ka.in[i];
        TW(0) TW(1) TW(2) TW(3) TW(4) TW(5) TW(6) TW(7) TW(8) TW(9) TW(10) TW(11) TW(12) TW(13) TW(14) TW(15) TW(16) TW(17) TW(18) TW(19) TW(20) TW(21)
        TW(22) TW(23) TW(24) TW(25) TW(26) TW(27) TW(28) TW(29) TW(30) TW(31) TW(32) TW(33) TW(34) TW(35) TW(36) TW(37) TW(38) TW(39) TW(40) TW(41) TW(42) TW(43)
#undef TW
        tab[N_IN] = (const float*)ka.out;
        __threadfence();
    }
    volatile LAS unsigned* xst = (volatile LAS unsigned*)((LAS unsigned char*)lds + (LDS_BYTES - 64));
    if (tid < 2) xst[tid] = 0u;
    __syncthreads();
    cg::this_grid().sync();
    XcdBarrier xbar = xcd_barrier_post((unsigned*)(ka.ws + WS_BAR), xst, wvs);
#ifndef NO_P0
    { MKCTX(); for (int rep = 0; rep < REP_P0; ++rep) phase0(a, wvs, lds); }
#endif
    GSYNC();
#pragma unroll 1
    for (int l = 0; l < DEPTH; ++l) {
        const bool ctx_out = l < DEPTH - 1;
#ifndef NO_NORM
        { MKCTX(); for (int rep = 0; rep < REP_CONV; ++rep) convert_weights(a, wvs, lds, l); for (int rep = 0; rep < REP_NORM; ++rep) norm_phase(a, wvs, l); }
#endif
        GSYNC();
        {
            unsigned char* ws = as_global(launder(ka.ws));
            const int mrows = ctx_out ? TOK : TOKL;
            pg8::Gemm g{(const bf16_t*)(ws + WS_H), (const bf16_t*)(ws + WS_WTMAIN), mrows, NMAIN, DM, nullptr, nullptr};
            pg8::StaticOrder S; S.init(mrows, NMAIN, G, bid);
            pg8::EpiBf16<0> E{(bf16_t*)(ws + WS_PROJ), NMAIN, nullptr, 0, 0, 1.f, nullptr, 0};
            for (int rep = 0; rep < REP_INPROJ; ++rep) pg8::gemm_phase<pg8::EpiBf16<0>, pg8::StaticOrder, true, true>(glds, g, S, E, wvs);
        }
        {
            unsigned char* ws = as_global(launder(ka.ws));
            const int crows = ctx_out ? 0 : TOKC;
            pg8::Gemm g{(const bf16_t*)(ws + WS_H) + (size_t)TOKL * DM, (const bf16_t*)(ws + WS_WTMAIN), crows, 3072, DM, nullptr, nullptr};
            pg8::StaticOrder S; S.init(crows, 3072, G, bid);
            pg8::EpiBf16<0> E{(bf16_t*)(ws + WS_PROJ) + (size_t)TOKL * NMAIN, NMAIN, nullptr, 0, 0, 1.f, nullptr, 0};
            pg8::gemm_phase<pg8::EpiBf16<0>, pg8::StaticOrder, true, true>(glds, g, S, E, wvs);
        }
        {
            unsigned char* ws = as_global(launder(ka.ws));
            const int ntok = ctx_out ? TOK : TOKL;
            pg8::Gemm g{(const bf16_t*)(ws + WS_WTHY), (const bf16_t*)(ws + WS_H), 1536, ntok, DM, nullptr, nullptr};
            pg8::StaticOrder S; S.init(1536, ntok, G, (bid + (G >> 1)) % G);
            pg8::EpiBf16<0> E{(bf16_t*)(ws + WS_HYT), TOK, nullptr, 0, 0, 1.f, nullptr, 0};
            for (int rep = 0; rep < REP_HYPROJ; ++rep) pg8::gemm_phase<pg8::EpiBf16<0>, pg8::StaticOrder, true, true>(glds, g, S, E, wvs);
        }
        GSYNC();
        {
#ifndef NO_RWKV
        { MKCTX();
        for (int rep = 0; rep < REP_RWKV; ++rep) for (int it = bid; it < 256; it += G) rwkv_chain(a, wvs, lds, l, it >> 4, (it >> 1) & 7, it & 1); }
#endif
#ifndef NO_S5
        { MKCTX();
        for (int rep = 0; rep < REP_S5; ++rep) for (int it = bid; it < 256; it += G) {
            const int wv = wvs;
            if (wv < 4) { const int pr = 2 * it + (wv >> 1); s5_chain(a, wvs, lds + wv * 25088, l, pr >> 5, pr & 31, wv & 1); }
            __builtin_amdgcn_fence(__ATOMIC_RELEASE, "workgroup"); __syncthreads(); __builtin_amdgcn_fence(__ATOMIC_ACQUIRE, "workgroup");
            s5_combine(a, wvs, l, 2 * it);
        } }
#endif
        __syncthreads();
#ifndef NO_ATT
        { MKCTX();
        for (int rep = 0; rep < REP_ATT; ++rep) for (int it = bid; it < 1024 + (ctx_out ? 128 : 0); it += G) {
            if (it < 1024) attn_unit(a, wvs, lds, l, it >> 6, it & 3, (it >> 2) & 15, false);
            else { const int r = it - 1024; attn_unit(a, wvs, lds, l, r >> 3, r & 3, (r >> 2) & 1, true); }
        } }
#endif
        __syncthreads();
#ifndef NO_HY
        { MKCTX();
        for (int rep = 0; rep < REP_HY; ++rep) for (int it = bid; it < 512 * (ctx_out ? 2 : 1); it += G) hyena_item(a, wvs, lds, l, it & 511, it >= 512); }
#endif
        }
        GSYNC();
        {
            unsigned char* ws = as_global(launder(ka.ws));
            const int ntok = ctx_out ? TOK : TOKL;
            pg8::Gemm g{(const bf16_t*)(ws + WS_YGELU), (const bf16_t*)(ws + WS_WTGLU), ntok, 512, 512, nullptr, nullptr};
            pg8::StaticOrder S; S.init(ntok, 512, G, bid);
            pg8::EpiBf16<0> E{(bf16_t*)(ws + WS_ZGLU), 512, nullptr, 0, 0, 1.f, nullptr, 0};
            for (int rep = 0; rep < REP_GLU; ++rep) pg8::gemm_phase<pg8::EpiBf16<0>, pg8::StaticOrder, true, true>(glds, g, S, E, wvs);
        }
        GSYNC();
#ifndef NO_MERGE
        { MKCTX(); for (int rep = 0; rep < REP_MERGE; ++rep) merge_phase(a, wvs, lds, l); }
#endif
        GSYNC();
        {
            MKCTX(); unsigned char* ws = a.ws;
            const int ntok = ctx_out ? TOK : TOKL;
            pg8::Gemm g{(const bf16_t*)(ws + WS_YMIX), (const bf16_t*)(ws + WS_WTOUT), ntok, DM, DM, nullptr, nullptr};
            pg8::StaticOrder S; S.init(ntok, DM, G, bid);
            EpiResid E{l == 0 ? a.in[I_X] : a.out, l == 0 ? a.in[I_CTX] : (const float*)(ws + WS_XC), a.out, (float*)(ws + WS_XC), (const float*)(ws + WS_MOD) + (size_t)l * 17 * 6144};
            pg8::gemm_phase<EpiResid, pg8::StaticOrder, true, true>(glds, g, S, E, wvs);
        }
        GSYNC();
    }
}

extern "C" void kernel_launch(void* const* d_in, const int* in_sizes, int n_in, void* d_out, int out_size, void* d_ws, size_t ws_size, hipStream_t stream) {
    static int grid = 0;
    if (grid == 0) {
        if (n_in != N_IN || ws_size < WS_END) { fprintf(stderr, "kernel_launch: unexpected inputs (n_in %d, ws %zu, need %zu)\n", n_in, ws_size, (size_t)WS_END); grid = -1; return; }
        int dev = 0, cus = 0, per_cu = 0;
        hipGetDevice(&dev);
        hipDeviceGetAttribute(&cus, hipDeviceAttributeMultiprocessorCount, dev);
        if (hipFuncSetAttribute((const void*)fwd_mega, hipFuncAttributeMaxDynamicSharedMemorySize, LDS_BYTES) != hipSuccess) { fprintf(stderr, "kernel_launch: hipFuncSetAttribute failed\n"); grid = -1; return; }
        if (hipOccupancyMaxActiveBlocksPerMultiprocessor(&per_cu, (const void*)fwd_mega, NTHR, LDS_BYTES) != hipSuccess || per_cu < 1) { fprintf(stderr, "kernel_launch: occupancy query says %d\n", per_cu); per_cu = 1; }
        (void)hipGetLastError();
        grid = cus * 1;
    }
    if (grid < 0) return;
    if (hipMemsetAsync((char*)d_ws + WS_BAR, 0, 16384, stream) != hipSuccess) { fprintf(stderr, "kernel_launch: memset failed\n"); return; }
    Args a{};
    for (int i = 0; i < N_IN; ++i) a.in[i] = (const float*)d_in[i];
    a.out = (float*)d_out; a.ws = (unsigned char*)d_ws;
    void* args[] = {&a};
    hipError_t e = hipLaunchCooperativeKernel((const void*)fwd_mega, dim3(grid), dim3(NTHR), args, LDS_BYTES, stream);
    if (e != hipSuccess) fprintf(stderr, "cooperative launch failed: %s (grid %d)\n", hipGetErrorString(e), grid);
}
```
